# Optimizing an MI355X kernel written in HIP

```python
import jax, jax.numpy as jnp
from jax import lax
import numpy as np

D_MODEL = 2048
BATCH = 4
SEQ = 4096
DEPTH = 2

GRID_W = 64
CTX_LEN = 256
D_MIX = D_MODEL
REC_WIDTH = D_MIX // 2
REC_BLOCKS = 8
REC_BLOCK_W = REC_WIDTH // REC_BLOCKS
CONV_W = 4
LRU_C = 8.0
N_HEADS = 8
QK_NOPE_DIM = 128
QK_ROPE_DIM = 64
QK_HEAD_DIM = QK_NOPE_DIM + QK_ROPE_DIM
V_HEAD_DIM = 128
ATT_WIDTH = N_HEADS * V_HEAD_DIM
Q_RANK = 512
KV_RANK = 256
ROPE_AXIS_DIM = QK_ROPE_DIM // 2
ROPE_BASE = 10000.0
ATT_SCALE = QK_HEAD_DIM ** -0.5
Q_BLOCK = 128
N_EXPERTS = 16
EC_CAPACITY = 2
D_EXPERT = 2048
N_MOD = 6
IN_WIDTH = 2 * REC_WIDTH + Q_RANK + KV_RANK + QK_ROPE_DIM
IN_SPLITS = (REC_WIDTH, 2 * REC_WIDTH, 2 * REC_WIDTH + Q_RANK, 2 * REC_WIDTH + Q_RANK + KV_RANK)
EPS = 1e-6

kernel_name = "hybrid_rglru_mla_ecmoe_diffusion_block"


def rms_norm(x, g):
    xf = x.astype(jnp.float32)
    y = xf * lax.rsqrt(jnp.mean(xf * xf, axis=-1, keepdims=True) + EPS)
    return y.astype(x.dtype) * g


def modulate(h, shift, scale):
    return h * (1 + scale) + shift


def axial_rope_tables(rows):
    row = jnp.repeat(jnp.arange(rows, dtype=jnp.float32), GRID_W)
    col = jnp.tile(jnp.arange(GRID_W, dtype=jnp.float32), rows)
    half = ROPE_AXIS_DIM // 2
    inv = ROPE_BASE ** (-jnp.arange(half, dtype=jnp.float32) / half)
    ang_r = row[:, None] * inv
    ang_c = col[:, None] * inv
    return (jnp.cos(ang_r), jnp.sin(ang_r), jnp.cos(ang_c), jnp.sin(ang_c))


def rotate(x, cos, sin):
    cos = cos[:, None, :].astype(x.dtype)
    sin = sin[:, None, :].astype(x.dtype)
    x1, x2 = jnp.split(x, 2, axis=-1)
    return jnp.concatenate([x1 * cos - x2 * sin, x2 * cos + x1 * sin], axis=-1)


def rope_head(x, tabs):
    cos_r, sin_r, cos_c, sin_c = tabs
    nope, rp = jnp.split(x, [QK_NOPE_DIM], axis=-1)
    pr, pc = jnp.split(rp, 2, axis=-1)
    return jnp.concatenate([nope, rotate(pr, cos_r, sin_r), rotate(pc, cos_c, sin_c)], axis=-1)


def centred_dwconv(x, w, b):
    T = x.shape[1]
    left = CONV_W // 2
    xp = jnp.pad(x, ((0, 0), (left, CONV_W - 1 - left), (0, 0)))
    out = b
    for k in range(CONV_W):
        out = out + xp[:, k:k + T] * w[k]
    return out


def _lin_combine(e1, e2):
    a1, b1 = e1
    a2, b2 = e2
    return a1 * a2, a2 * b1 + b2


def block_diag(u, w):
    B, T, W = u.shape
    ub = u.reshape(B, T, REC_BLOCKS, REC_BLOCK_W)
    return jnp.einsum('btgi,gij->btgj', ub, w).reshape(B, T, W)


def rg_lru(u, wa, ba, wx, bx, lam, h0, reverse):
    T = u.shape[1]
    r = jax.nn.sigmoid((block_diag(u, wa) + ba).astype(jnp.float32))
    i = jax.nn.sigmoid((block_diag(u, wx) + bx).astype(jnp.float32))
    log_a = LRU_C * r * jax.nn.log_sigmoid(lam.astype(jnp.float32))
    a = jnp.exp(log_a)
    b = jnp.sqrt(-jnp.expm1(2.0 * log_a)) * (i * u.astype(jnp.float32))
    edge = T - 1 if reverse else 0
    b = b.at[:, edge].add(a[:, edge] * h0)
    _, h = lax.associative_scan(_lin_combine, (a, b), axis=1, reverse=reverse)
    return h


def mla_q(cq, p, tabs):
    B, T, _ = cq.shape
    q = (rms_norm(cq, p['q_a_norm']) @ p['w_uq']).reshape(B, T, N_HEADS, QK_HEAD_DIM)
    q = rms_norm(q, p['q_norm'])
    return q if tabs is None else rope_head(q, tabs)


def mla_kv(ckv, kr, p, tabs):
    B, T, _ = ckv.shape
    kv = (rms_norm(ckv, p['kv_a_norm']) @ p['w_ukv']).reshape(B, T, N_HEADS, QK_NOPE_DIM + V_HEAD_DIM)
    k_nope, v = jnp.split(kv, [QK_NOPE_DIM], axis=-1)
    k_rope = jnp.broadcast_to(kr[:, :, None, :], (B, T, N_HEADS, QK_ROPE_DIM))
    k = rms_norm(jnp.concatenate([k_nope, k_rope], axis=-1), p['k_norm'])
    k = k if tabs is None else rope_head(k, tabs)
    return k, v


def block_attention(q, k, v):
    B, T, H, Dq = q.shape
    nb = T // Q_BLOCK
    qb = q.reshape(B, nb, Q_BLOCK, H, Dq).transpose(1, 0, 2, 3, 4)

    def one(qi):
        s = jnp.einsum('bqhd,bkhd->bhqk', qi, k).astype(jnp.float32) * ATT_SCALE
        pr = jax.nn.softmax(s, axis=-1).astype(v.dtype)
        return jnp.einsum('bhqk,bkhd->bqhd', pr, v)

    o = lax.map(one, qb)
    return o.transpose(1, 0, 2, 3, 4).reshape(B, T, H * v.shape[-1])


def ec_moe(h, w_router, w_gate, w_up, w_down):
    B, T, D = h.shape
    cap = EC_CAPACITY * T // N_EXPERTS
    aff = jax.nn.softmax((h @ w_router).astype(jnp.float32), axis=-1)
    gate, idx = lax.top_k(aff.transpose(0, 2, 1), cap)
    b_ix = jnp.arange(B)[:, None, None]
    xg = h[b_ix, idx]
    a = jnp.einsum('becd,edf->becf', xg, w_gate)
    u = jnp.einsum('becd,edf->becf', xg, w_up)
    y = jnp.einsum('becf,efd->becd', jax.nn.silu(a) * u, w_down) * gate[..., None].astype(h.dtype)
    return jnp.zeros_like(h).at[b_ix, idx].add(y)


def mixer_out(y_rec_f32, gr, y_att, w_out, dtype):
    y_rec = y_rec_f32.astype(dtype) * jax.nn.gelu(gr)
    return jnp.concatenate([y_rec, y_att], axis=-1) @ w_out


def layer(x, cx, c, c_ctx, p, tabs, last):
    B = x.shape[0]
    mod = (jax.nn.silu(c) @ p['w_mod'] + p['b_mod'])[:, None, :]
    mod_c = jax.nn.silu(c_ctx) @ p['w_mod'] + p['b_mod']
    sh1, sc1, g1, sh2, sc2, g2 = jnp.split(mod, N_MOD, axis=-1)
    sh1c, sc1c, g1c, sh2c, sc2c, g2c = jnp.split(mod_c, N_MOD, axis=-1)

    z = modulate(rms_norm(x, p['norm1']), sh1, sc1) @ p['w_in']
    zc = modulate(rms_norm(cx, p['norm1']), sh1c, sc1c) @ p['w_in']
    xr, gr, cq, ckv, kr = jnp.split(z, IN_SPLITS, axis=-1)
    xrc, grc, cqc, ckvc, krc = jnp.split(zc, IN_SPLITS, axis=-1)

    uc = centred_dwconv(xrc, p['conv_w'], p['conv_b'])
    ul = centred_dwconv(xr, p['conv_w'], p['conv_b'])
    zero = jnp.zeros((B, REC_WIDTH), jnp.float32)
    fwd = (p['lru_wa'][0], p['lru_ba'][0], p['lru_wx'][0], p['lru_bx'][0], p['lru_lambda'][0])
    bwd = (p['lru_wa'][1], p['lru_ba'][1], p['lru_wx'][1], p['lru_bx'][1], p['lru_lambda'][1])
    hcf = rg_lru(uc, *fwd, zero, False)
    hcb = rg_lru(uc, *bwd, zero, True)
    hlf = rg_lru(ul, *fwd, hcf[:, -1], False)
    hlb = rg_lru(ul, *bwd, hcb[:, 0], True)

    kc, vc = mla_kv(ckvc, krc, p, None)
    kl, vl = mla_kv(ckv, kr, p, tabs)
    ql = mla_q(cq, p, tabs)
    k_all = jnp.concatenate([kc, kl], axis=1)
    v_all = jnp.concatenate([vc, vl], axis=1)
    y_att = block_attention(ql, k_all, v_all)

    x_new = x + g1 * mixer_out(hlf + hlb, gr, y_att, p['w_out'], x.dtype)
    h2 = modulate(rms_norm(x_new, p['norm2']), sh2, sc2)
    x_new = x_new + g2 * ec_moe(h2, p['router'], p['w_gate'], p['w_up'], p['w_down'])

    if last:
        return x_new, cx
    qc = mla_q(cqc, p, None)
    y_att_c = block_attention(qc, kc, vc)
    cx_new = cx + g1c * mixer_out(hcf + hcb, grc, y_att_c, p['w_out'], cx.dtype)
    h2c = modulate(rms_norm(cx_new, p['norm2']), sh2c, sc2c)
    cx_new = cx_new + g2c * ec_moe(h2c, p['router'], p['w_gate'], p['w_up'], p['w_down'])
    return x_new, cx_new


def setup_inputs(seed: int = 0) -> dict:
    key = jax.random.key(seed)
    ks = jax.random.split(key, 32)
    f32 = jnp.float32
    nrm = lambda k, shape, s: jax.random.normal(k, shape, f32) * s
    gain = lambda k, shape: 1.0 + 0.05 * jax.random.normal(k, shape, f32)
    D = D_MODEL
    a0 = jax.random.uniform(ks[14], (DEPTH, 2, REC_WIDTH), f32, 0.9, 0.999)
    return {
        'x': nrm(ks[0], (BATCH, SEQ, D), 1.0),
        'c': nrm(ks[1], (BATCH, D), 1.0),
        'ctx': nrm(ks[2], (BATCH, CTX_LEN, D), 1.0),
        'c_ctx': nrm(ks[3], (D,), 1.0),
        'w_mod': nrm(ks[4], (DEPTH, D, N_MOD * D), 0.5 * D ** -0.5),
        'b_mod': nrm(ks[5], (DEPTH, N_MOD * D), 0.02),
        'norm1': gain(ks[6], (DEPTH, D)),
        'w_in': nrm(ks[7], (DEPTH, D, IN_WIDTH), D ** -0.5),
        'conv_w': nrm(ks[8], (DEPTH, CONV_W, REC_WIDTH), CONV_W ** -0.5),
        'conv_b': nrm(ks[9], (DEPTH, REC_WIDTH), 0.02),
        'lru_wa': nrm(ks[10], (DEPTH, 2, REC_BLOCKS, REC_BLOCK_W, REC_BLOCK_W), REC_BLOCK_W ** -0.5),
        'lru_ba': nrm(ks[11], (DEPTH, 2, REC_WIDTH), 0.1),
        'lru_wx': nrm(ks[12], (DEPTH, 2, REC_BLOCKS, REC_BLOCK_W, REC_BLOCK_W), REC_BLOCK_W ** -0.5),
        'lru_bx': nrm(ks[13], (DEPTH, 2, REC_WIDTH), 0.1),
        'lru_lambda': jnp.log(a0) - jnp.log1p(-a0),
        'q_a_norm': gain(ks[15], (DEPTH, Q_RANK)),
        'w_uq': nrm(ks[16], (DEPTH, Q_RANK, N_HEADS * QK_HEAD_DIM), Q_RANK ** -0.5),
        'kv_a_norm': gain(ks[17], (DEPTH, KV_RANK)),
        'w_ukv': nrm(ks[18], (DEPTH, KV_RANK, N_HEADS * (QK_NOPE_DIM + V_HEAD_DIM)), KV_RANK ** -0.5),
        'q_norm': gain(ks[19], (DEPTH, QK_HEAD_DIM)),
        'k_norm': gain(ks[20], (DEPTH, QK_HEAD_DIM)),
        'w_out': nrm(ks[21], (DEPTH, D_MIX, D), D_MIX ** -0.5),
        'norm2': gain(ks[22], (DEPTH, D)),
        'router': nrm(ks[23], (DEPTH, D, N_EXPERTS), D ** -0.5),
        'w_gate': nrm(ks[24], (DEPTH, N_EXPERTS, D, D_EXPERT), D ** -0.5),
        'w_up': nrm(ks[25], (DEPTH, N_EXPERTS, D, D_EXPERT), D ** -0.5),
        'w_down': nrm(ks[26], (DEPTH, N_EXPERTS, D_EXPERT, D), D_EXPERT ** -0.5),
    }


def reference(x, c, ctx, c_ctx, w_mod, b_mod, norm1, w_in, conv_w, conv_b, lru_wa, lru_ba,
              lru_wx, lru_bx, lru_lambda, q_a_norm, w_uq, kv_a_norm, w_ukv, q_norm, k_norm,
              w_out, norm2, router, w_gate, w_up, w_down):
    rows = x.shape[1] // GRID_W
    tabs = axial_rope_tables(rows)
    cx = ctx
    for l in range(DEPTH):
        p = {
            'w_mod': w_mod[l], 'b_mod': b_mod[l], 'norm1': norm1[l], 'w_in': w_in[l],
            'conv_w': conv_w[l], 'conv_b': conv_b[l], 'lru_wa': lru_wa[l], 'lru_ba': lru_ba[l],
            'lru_wx': lru_wx[l], 'lru_bx': lru_bx[l], 'lru_lambda': lru_lambda[l],
            'q_a_norm': q_a_norm[l], 'w_uq': w_uq[l], 'kv_a_norm': kv_a_norm[l], 'w_ukv': w_ukv[l],
            'q_norm': q_norm[l], 'k_norm': k_norm[l], 'w_out': w_out[l], 'norm2': norm2[l],
            'router': router[l], 'w_gate': w_gate[l], 'w_up': w_up[l], 'w_down': w_down[l],
        }
        x, cx = layer(x, cx, c, c_ctx, p, tabs, l == DEPTH - 1)
    return x
```

```cpp
#include <hip/hip_runtime.h>
#include <cstdio>
#include <cstdint>

#define LAS __attribute__((address_space(3)))
#define GAS __attribute__((address_space(1)))
typedef unsigned short bf16;
typedef short bf16x8 __attribute__((ext_vector_type(8)));
typedef short s16x4 __attribute__((ext_vector_type(4)));
typedef float f32x4 __attribute__((ext_vector_type(4)));
typedef float f32x2 __attribute__((ext_vector_type(2)));
typedef float f32x16 __attribute__((ext_vector_type(16)));
typedef unsigned u32x4 __attribute__((ext_vector_type(4)));
typedef unsigned u32x2 __attribute__((ext_vector_type(2)));
typedef int v4i __attribute__((ext_vector_type(4)));
typedef int v8i __attribute__((ext_vector_type(8)));

#ifndef BG_FILL_GEMM_TAILS
#define BG_FILL_GEMM_TAILS 0
#endif
#ifndef MK_ONE_LAUNCH
#define MK_ONE_LAUNCH 1
#endif

constexpr int DM = 2048, NB = 4, SEQ = 4096, CTXL = 256;
constexpr int NL = NB * SEQ, NC = NB * CTXL, NR = NL + NC;
constexpr int RW = 1024, NH = 8, DQK = 192, DVH = 128;
constexpr int QRANK = 512, KVRANK = 256, INW = 2880, INWP = 3072;
constexpr int NE = 16, NMODW = 6 * DM;
constexpr int CAP_L = 512, CAP_C = 32, EROWS = 2304;
constexpr int KVLEN = CTXL + SEQ;
constexpr int NCHUNK = 68;
constexpr float EPS = 1e-6f;

constexpr size_t MiB = 1u << 20;
constexpr size_t WS_CTL = 0, CTL_BYTES = 1 * MiB;
constexpr size_t WS_MODV = 1 * MiB, WS_AFF = 2 * MiB, WS_SEL = 4 * MiB, WS_IDXR = 6 * MiB, WS_GATEV = 6 * MiB + 512 * 1024, WS_AGG = 8 * MiB, WS_CARRY = 13 * MiB, WS_LSL = 15 * MiB + 512 * 1024;
constexpr size_t WS_WSET = 16 * MiB, WSET_STRIDE = 410 * MiB;
constexpr size_t W_IN = 0, W_UQ = 12 * MiB, W_UKV = 14 * MiB, W_GT = 15 * MiB, W_OUT = 18 * MiB, W_GU = 26 * MiB, W_DN = 282 * MiB;
constexpr size_t WS_H = 836 * MiB, WS_U = 904 * MiB, WS_AB = 938 * MiB;
constexpr size_t WS_K = 1074 * MiB, WS_V = 1125 * MiB, WS_Y = 1159 * MiB, WS_XM = 1227 * MiB, WS_X1 = 1363 * MiB;
constexpr size_t WS_OV = 1499 * MiB;
constexpr size_t WS_XR = WS_OV, WS_GR = WS_OV + 34 * MiB, WS_CQ = WS_OV + 68 * MiB, WS_CKV = WS_OV + 85 * MiB, WS_KR = WS_OV + 94 * MiB, WS_QRAW = WS_OV + 99 * MiB, WS_SSQ = WS_OV + 150 * MiB, WS_RSTDK = WS_OV + 152 * MiB;
constexpr size_t WS_XG = WS_OV, WS_ACT = WS_OV + 144 * MiB, WS_YE = WS_OV + 288 * MiB, WS_END = WS_OV + 432 * MiB;
static_assert(WS_YE + (size_t)NE * EROWS * DM * 2 <= WS_END && WS_END <= 2048 * MiB, "workspace map");
constexpr int CW_QHEAD = 8192, CW_QDONE = 8256;
constexpr int T_SMALL = 32 * 45 + 8 * 24 + 4 * 32 + 32 * 32, T_MOE = 3 * NE * 32 * 32, T_LAYER = T_SMALL + T_MOE;
constexpr int BG_TILES = T_MOE + T_LAYER, BG_STEPS = BG_TILES / 8;
constexpr int BG_E0 = T_MOE / 8, BG_E1S = (T_MOE + T_SMALL) / 8, BG_E1 = BG_STEPS;
static_assert(T_MOE % 8 == 0 && T_SMALL % 8 == 0, "step granularity");

constexpr int CW_CTXMIX = 12000;
constexpr int LDS_BYTES = 163840;
constexpr int LDS_MISC = LDS_BYTES - 4096;

struct Args { const float* in[27]; float* out; unsigned char* ws; int ph_lo, ph_hi; };

__device__ __forceinline__ unsigned f2bf(float f) { unsigned u = __builtin_bit_cast(unsigned, f); return (u + 0x7fffu + ((u >> 16) & 1u)) >> 16; }
__device__ __forceinline__ unsigned pk2(float lo, float hi) { return f2bf(lo) | (f2bf(hi) << 16); }
__device__ __forceinline__ float bf2f(unsigned short b) { return __builtin_bit_cast(float, (unsigned)b << 16); }
__device__ __forceinline__ float bflo(unsigned w) { return __builtin_bit_cast(float, w << 16); }
__device__ __forceinline__ float bfhi(unsigned w) { return __builtin_bit_cast(float, w & 0xffff0000u); }
__device__ __forceinline__ float wave_sum(float v) {
#pragma unroll
    for (int o = 1; o < 64; o <<= 1) v += __shfl_xor(v, o);
    return v;
}
__device__ __forceinline__ float sigmoid_(float x) { return 1.f / (1.f + __expf(-x)); }
__device__ __forceinline__ float silu_(float x) { return x * sigmoid_(x); }
__device__ __forceinline__ float sigmoid_fast(float x) { return __builtin_amdgcn_rcpf(1.f + __expf(-x)); }
__device__ __forceinline__ float silu_fast(float x) { return x * sigmoid_fast(x); }
__device__ __forceinline__ float one_minus_exp(float x) { const float p = -x * (1.f + x * (0.5f + x * (0.16666667f + x * (0.041666668f + x * 0.0083333338f)))); return x > -0.1f ? p : 1.f - __expf(x); }
__device__ __forceinline__ float gelu_tanh_(float x) { const float u = 0.7978845608028654f * (x + 0.044715f * x * x * x); const float t = 1.f - 2.f / (1.f + __expf(2.f * u)); return 0.5f * x * (1.f + t); }
__device__ __forceinline__ float sat8(float x) { return __builtin_amdgcn_fmed3f(x, -448.f, 448.f); }
__device__ __forceinline__ unsigned pk4_fp8(float a, float b, float c, float d) { int w = __builtin_amdgcn_cvt_pk_fp8_f32(sat8(a), sat8(b), 0, false); w = __builtin_amdgcn_cvt_pk_fp8_f32(sat8(c), sat8(d), w, true); return (unsigned)w; }
constexpr float W8_SCALE = 64.f;
__device__ __forceinline__ float dot4(f32x4 a, f32x4 b) { return (a.x * b.x + a.y * b.y) + (a.z * b.z + a.w * b.w); }

#define XB_TMO      128
#define XB_XCNT(j)  (256  + 64 * (j))
#define XB_XSUB(j)  (1280 + 64 * (j))
#define XB_XGEN(j)  (2304 + 64 * (j))
#define XB_TOP      3328
#define XB_TOPGEN   3392
#define XCD_BAR_WORDS 3456
#define XB_SPIN_CAP (1u << 18)
__device__ __forceinline__ unsigned xb_ld(unsigned* p)              { return __hip_atomic_load(p, __ATOMIC_RELAXED, __HIP_MEMORY_SCOPE_AGENT); }
__device__ __forceinline__ unsigned xb_add(unsigned* p, unsigned v) { return __hip_atomic_fetch_add(p, v, __ATOMIC_RELAXED, __HIP_MEMORY_SCOPE_AGENT); }
__device__ __forceinline__ unsigned xb_xcc_id() { return (unsigned)__builtin_amdgcn_s_getreg((3 << 11) | 20) & 0xFu; }
#define XB_SPIN(cond, bar) do { unsigned _sp = 0; while (cond) { __builtin_amdgcn_s_sleep(1); \
    if ((++_sp & 255u) == 0u) { if (xb_ld(&(bar)[XB_TMO])) break; if (_sp > XB_SPIN_CAP) { atomicAdd(&(bar)[XB_TMO], 1u); break; } } } } while (0)
struct XcdBarrier { unsigned* bar; unsigned x; volatile LAS unsigned* st; };
__device__ __forceinline__ XcdBarrier xcd_barrier_post(unsigned* bar, volatile LAS unsigned* st) {
    XcdBarrier b; b.bar = bar; b.x = xb_xcc_id(); b.st = st;
    if (threadIdx.x == 0) st[2] = xb_add(&bar[XB_XCNT(b.x)], 1u);
    return b;
}
__device__ __forceinline__ void xcd_barrier_complete(unsigned* bar, unsigned x, unsigned& nloc, unsigned& nx) {
    const unsigned G = gridDim.x * gridDim.y * gridDim.z;
    unsigned sum, cnt, mine, sp = 0u;
    for (;;) {
        sum = 0u; cnt = 0u; mine = 0u;
#pragma unroll
        for (unsigned j = 0; j < 16; ++j) { const unsigned c = xb_ld(&bar[XB_XCNT(j)]); sum += c; cnt += (c > 0u) ? 1u : 0u; mine = (j == x) ? c : mine; }
        if (sum == G) break;
        __builtin_amdgcn_s_sleep(1);
        if ((++sp & 255u) == 0u) { if (xb_ld(&bar[XB_TMO])) break; if (sp > XB_SPIN_CAP) { atomicAdd(&bar[XB_TMO], 1u); break; } }
    }
    nloc = mine > 0u ? mine : 1u; nx = cnt > 0u ? cnt : 1u;
}
__device__ __forceinline__ void xcd_barrier(const XcdBarrier& b) {
    asm volatile("s_waitcnt vmcnt(0)" ::: "memory");
    __syncthreads();
    if (threadIdx.x == 0) {
        unsigned* bar = b.bar;
        __builtin_amdgcn_s_waitcnt(0);
        unsigned nloc = b.st[0], nx = b.st[1];
        if (nloc == 0u) { xcd_barrier_complete(bar, b.x, nloc, nx); b.st[0] = nloc; b.st[1] = nx; }
        const unsigned old = xb_add(&bar[XB_XSUB(b.x)], 1u);
        const unsigned gen = old / nloc;
        if (old + 1u == (gen + 1u) * nloc) {
            __builtin_amdgcn_fence(__ATOMIC_RELEASE, "agent");
            asm volatile("s_waitcnt vmcnt(0)" ::: "memory");
            const unsigned og = xb_add(&bar[XB_TOP], 1u);
            const unsigned tg = og / nx;
            if (og + 1u == (tg + 1u) * nx) xb_add(&bar[XB_TOPGEN], 1u);
            else XB_SPIN(xb_ld(&bar[XB_TOPGEN]) == tg, bar);
            __builtin_amdgcn_fence(__ATOMIC_ACQUIRE, "agent");
            xb_add(&bar[XB_XGEN(b.x)], 1u);
            asm volatile("s_waitcnt vmcnt(0)" ::: "memory");
        } else {
            XB_SPIN(xb_ld(&bar[XB_XGEN(b.x)]) == gen, bar);
            __builtin_amdgcn_fence(__ATOMIC_ACQUIRE, "agent");
            asm volatile("s_waitcnt vmcnt(0)" ::: "memory");
        }
    }
    __syncthreads();
}

namespace pg8 {
constexpr int BM = 256, BK = 64, HALF = 128, HTB = HALF * BK * 2, STAGE_BYTES = 8 * HTB, NXCD = 8, WGM = 8;
__device__ __forceinline__ int lds_byte(int r, int c) { const int st = (r >> 4) * 2 + (c >> 5), rr = r & 15, cc = c & 31, ob = rr * 64 + cc * 2; return st * 1024 + (ob ^ (((ob >> 9) & 1) << 5)); }
__device__ __forceinline__ void stage_rc(int b, int& R, int& C) { const int st = b / 1024, sb = b % 1024, swz = sb ^ (((sb >> 9) & 1) << 5); R = (st >> 1) * 16 + swz / 64; C = (st & 1) * 32 + (swz % 64) / 2; }
__device__ __forceinline__ int perm32(int rho) { const int n = rho >> 4, i = rho & 15; return 8 * (i >> 2) + 4 * n + (i & 3); }
struct Unit { int pm, pn; };
struct TileOrder {
    int nM, nN, nwg, G, c, wgm;
    __device__ __forceinline__ void init(int nM_, int nN_, int G_, int c_, int wgm_ = WGM) { nM = nM_; nN = nN_; nwg = nM * nN; G = G_; c = c_; wgm = wgm_; }
    __device__ __forceinline__ bool next(int i, Unit& u) const {
        const long L = (long)i * G + c; if (L >= nwg) return false;
        int wgid = (int)L; { const int q = nwg / NXCD, r = nwg % NXCD, xcd = wgid % NXCD, off = wgid / NXCD; wgid = (xcd < r ? xcd * (q + 1) : r * (q + 1) + (xcd - r) * q) + off; }
        const int nig = wgm * nN, gid = wgid / nig, fm = gid * wgm, gsz = (nM - fm) < wgm ? (nM - fm) : wgm;
        u.pm = fm + ((wgid % nig) % gsz); u.pn = (wgid % nig) / gsz; return true;
    }
};
template <class P>
__device__ __forceinline__ void gemm_phase(LAS unsigned char* lds, const P& p) {
    int tid_ = threadIdx.x; asm volatile("" : "+v"(tid_));
    const int tid = tid_, wid = __builtin_amdgcn_readfirstlane(tid >> 6), lane = tid & 63, wr = wid >> 2, wc = wid & 3, fr = lane & 15, fq = lane >> 4;
    constexpr int EB = P::EB;
    int nt_ = p.K * EB / 128; asm volatile("" : "+s"(nt_)); const int nt = nt_;
    unsigned voffA[2], voffB[2];
#pragma unroll
    for (int i = 0; i < 2; ++i) { int R, C; stage_rc(tid * 16 + i * 8192, R, C); const int Rb = P::PERM ? ((R & ~31) + perm32(R & 31)) : R;
        voffA[i] = (unsigned)(R * p.lda * EB + C * 2); voffB[i] = (unsigned)(Rb * p.ldb * EB + C * 2); }
    const size_t kstep = 128;
    const size_t hstepA = (size_t)HALF * p.lda * EB, hstepB = (size_t)HALF * p.ldb * EB;
    const unsigned ldsw = (unsigned)wid * 1024u;
    const int aoff = EB == 2 ? lds_byte(wr * 64 + fr, fq * 8) : lds_byte(wr * 64 + fr, (fq & 1) * 16) + (fq >> 1) * 1024;
    const int boff = EB == 2 ? lds_byte(wc * 32 + fr, fq * 8) : lds_byte(wc * 32 + fr, (fq & 1) * 16) + (fq >> 1) * 1024;
    constexpr int KOFF = EB == 2 ? 1024 : 16;
    const int sc1 = 0x7f7f7f7f;
#define PG8_SA(b, h) (((b) * 2 + (h)) * HTB)
#define PG8_SB(b, h) ((4 + (b) * 2 + (h)) * HTB)
#define PG8_STAGE(bufoff, gbase, voff) do { _Pragma("unroll") for (int _i = 0; _i < 2; ++_i) \
        __builtin_amdgcn_global_load_lds((const unsigned*)((const char*)(gbase) + (voff)[_i]), (LAS unsigned*)(lds + (bufoff) + ldsw + _i * 8192), 16, 0, 0); } while (0)
#define PG8_LDA(dst, b, h) do { _Pragma("unroll") for (int m = 0; m < 4; ++m) _Pragma("unroll") for (int k = 0; k < 2; ++k) dst[m][k] = *(const LAS v4i*)(lds + PG8_SA(b, h) + aoff + m * 2048 + k * KOFF); } while (0)
#define PG8_LDB(dst, b, h) do { _Pragma("unroll") for (int n = 0; n < 2; ++n) _Pragma("unroll") for (int k = 0; k < 2; ++k) dst[n][k] = *(const LAS v4i*)(lds + PG8_SB(b, h) + boff + n * 2048 + k * KOFF); } while (0)
#define PG8_MMA(ai, bj, At, Bt) do { __builtin_amdgcn_s_setprio(1); _Pragma("unroll") for (int m = 0; m < 4; ++m) _Pragma("unroll") for (int n = 0; n < 2; ++n) { \
        if constexpr (EB == 2) { _Pragma("unroll") for (int k = 0; k < 2; ++k) acc[ai][bj][m][n] = __builtin_amdgcn_mfma_f32_16x16x32_bf16(__builtin_bit_cast(bf16x8, Bt[n][k]), __builtin_bit_cast(bf16x8, At[m][k]), acc[ai][bj][m][n], 0, 0, 0); } \
        else { const v8i bq_ = __builtin_shufflevector(Bt[n][0], Bt[n][1], 0, 1, 2, 3, 4, 5, 6, 7), aq_ = __builtin_shufflevector(At[m][0], At[m][1], 0, 1, 2, 3, 4, 5, 6, 7); \
            asm volatile("v_mfma_scale_f32_16x16x128_f8f6f4 %0, %1, %2, %0, %3, %3 op_sel_hi:[0,0,0]" : "+v"(acc[ai][bj][m][n]) : "v"(bq_), "v"(aq_), "v"(sc1)); } } \
        __builtin_amdgcn_s_setprio(0); } while (0)
#define PG8_WAIT_V(n) asm volatile("s_waitcnt vmcnt(" #n ")" ::: "memory")
#define PG8_WAIT_L(n) asm volatile("s_waitcnt lgkmcnt(" #n ")" ::: "memory")
#define PG8_BAR __builtin_amdgcn_s_barrier()
#define PG8_SCHED __builtin_amdgcn_sched_barrier(0)
    Unit cur, nxt; int ui = 0;
    if (!p.ord.next(0, cur)) return;
    f32x4 acc[2][2][4][2];
#pragma unroll
    for (int a = 0; a < 2; ++a)
#pragma unroll
        for (int b = 0; b < 2; ++b)
#pragma unroll
            for (int m = 0; m < 4; ++m)
#pragma unroll
                for (int n = 0; n < 2; ++n) acc[a][b][m][n] = (f32x4){0.f, 0.f, 0.f, 0.f};
    v4i At[4][2], B0[2][2], B1[2][2];
    const char* cA = p.a_base(cur); const char* cB = p.b_base(cur);
    PG8_STAGE(PG8_SB(0, 0), cB, voffB); PG8_STAGE(PG8_SB(0, 1), cB + hstepB, voffB); PG8_STAGE(PG8_SA(0, 0), cA, voffA); PG8_STAGE(PG8_SA(0, 1), cA + hstepA, voffA);
    if (wr == 1) PG8_BAR;
    PG8_WAIT_V(2); PG8_BAR;
    PG8_STAGE(PG8_SB(1, 0), cB + kstep, voffB); PG8_STAGE(PG8_SA(1, 0), cA + kstep, voffA); PG8_STAGE(PG8_SB(1, 1), cB + hstepB + kstep, voffB);
    PG8_WAIT_V(6); PG8_BAR;
    for (;;) {
        const bool has_next = p.ord.next(ui + 1, nxt);
        const char* nA = has_next ? p.a_base(nxt) : cA; const char* nB = has_next ? p.b_base(nxt) : cB;
        for (int t = 0; t < nt; t += 2) {
            const bool last = (t == nt - 2);
            const char* a1 = cA + (size_t)(t + 1) * kstep;
            const char* a2 = last ? nA : cA + (size_t)(t + 2) * kstep; const char* b2 = last ? nB : cB + (size_t)(t + 2) * kstep;
            const char* a3 = a2 + kstep; const char* b3 = b2 + kstep;
            PG8_LDB(B0, 0, 0); PG8_LDB(B1, 0, 1); PG8_SCHED; PG8_LDA(At, 0, 0); PG8_STAGE(PG8_SA(1, 1), a1 + hstepA, voffA);
            PG8_WAIT_V(8); PG8_WAIT_L(0); PG8_BAR; PG8_MMA(0, 0, At, B0); PG8_MMA(0, 1, At, B1); PG8_BAR; PG8_SCHED;
            PG8_LDA(At, 0, 1); PG8_STAGE(PG8_SB(0, 0), b2, voffB); PG8_STAGE(PG8_SB(0, 1), b2 + hstepB, voffB); PG8_STAGE(PG8_SA(0, 0), a2, voffA);
            PG8_WAIT_V(8); PG8_WAIT_L(0); PG8_BAR; PG8_MMA(1, 0, At, B0); PG8_MMA(1, 1, At, B1); PG8_BAR; PG8_SCHED;
            PG8_LDB(B0, 1, 0); PG8_LDB(B1, 1, 1); PG8_SCHED; PG8_LDA(At, 1, 0); PG8_STAGE(PG8_SA(0, 1), a2 + hstepA, voffA);
            PG8_WAIT_V(8); PG8_WAIT_L(0); PG8_BAR; PG8_MMA(0, 0, At, B0); PG8_MMA(0, 1, At, B1); PG8_BAR; PG8_SCHED;
            PG8_LDA(At, 1, 1); PG8_STAGE(PG8_SB(1, 0), b3, voffB); PG8_STAGE(PG8_SB(1, 1), b3 + hstepB, voffB); PG8_STAGE(PG8_SA(1, 0), a3, voffA);
            PG8_WAIT_V(8); PG8_WAIT_L(0); PG8_BAR; PG8_MMA(1, 0, At, B0); PG8_MMA(1, 1, At, B1); PG8_BAR; PG8_SCHED;
        }
        if (wr == 0) PG8_BAR;
        p.epi(acc, cur, wr, wc, fr, fq);
        if (!has_next) break;
#pragma unroll
        for (int a = 0; a < 2; ++a)
#pragma unroll
            for (int b = 0; b < 2; ++b)
#pragma unroll
                for (int m = 0; m < 4; ++m)
#pragma unroll
                    for (int n = 0; n < 2; ++n) acc[a][b][m][n] = (f32x4){0.f, 0.f, 0.f, 0.f};
        cur = nxt; cA = nA; cB = nB; ++ui;
        if (wr == 1) PG8_BAR;
    }
    PG8_WAIT_V(0);
    PG8_BAR;
#undef PG8_SA
#undef PG8_SB
#undef PG8_STAGE
#undef PG8_LDA
#undef PG8_LDB
#undef PG8_MMA
#undef PG8_WAIT_V
#undef PG8_WAIT_L
#undef PG8_BAR
#undef PG8_SCHED
}
}
using pg8::Unit;

struct ProbIn {
    static constexpr bool PERM = true; static constexpr int EB = 2;
    int K, lda, ldb; pg8::TileOrder ord; const char* A; const char* Bt; bf16* XR; bf16* GR; bf16* CQ; bf16* CKV; float* KR; float* SSQ;
    __device__ __forceinline__ const char* a_base(const Unit& u) const { return A + (size_t)u.pm * 256 * lda * 2; }
    __device__ __forceinline__ const char* b_base(const Unit& u) const { return Bt + (size_t)u.pn * 256 * ldb * 2; }
    __device__ __forceinline__ void epi(const f32x4 (&acc)[2][2][4][2], const Unit& u, int wr, int wc, int fr, int fq) const {
        const int pn = u.pn; const size_t rowt = (size_t)u.pm * 256;
        unsigned lrow = (unsigned)(wr * 64 + fr), lcol = (unsigned)(wc * 32 + 8 * fq); asm volatile("" : "+v"(lrow), "+v"(lcol));
        if (pn < 11) {
            bf16* dst; int ld;
            if (pn < 4) { dst = XR + rowt * 1024 + pn * 256; ld = 1024; } else if (pn < 8) { dst = GR + rowt * 1024 + (pn - 4) * 256; ld = 1024; }
            else if (pn < 10) { dst = CQ + rowt * 512 + (pn - 8) * 256; ld = 512; } else { dst = CKV + rowt * 256; ld = 256; }
            const unsigned loff = (lrow * (unsigned)ld + lcol) * 2u;
#pragma unroll
            for (int ai = 0; ai < 2; ++ai)
#pragma unroll
                for (int m = 0; m < 4; ++m) {
#pragma unroll
                    for (int bj = 0; bj < 2; ++bj) { const f32x4 v0 = acc[ai][bj][m][0], v1 = acc[ai][bj][m][1];
                        u32x4 w; w.x = pk2(v0[0], v0[1]); w.y = pk2(v0[2], v0[3]); w.z = pk2(v1[0], v1[1]); w.w = pk2(v1[2], v1[3]);
                        *(u32x4*)((char*)dst + ((size_t)(ai * 128 + m * 16) * ld + bj * 128) * 2 + loff) = w; } }
            if (pn >= 8) {
                float* sq = SSQ + rowt * 16 + (pn < 10 ? (pn - 8) * 4 : 8) + wc;
#pragma unroll
                for (int ai = 0; ai < 2; ++ai)
#pragma unroll
                    for (int m = 0; m < 4; ++m) { float ss = 0.f;
#pragma unroll
                        for (int bj = 0; bj < 2; ++bj)
#pragma unroll
                            for (int n = 0; n < 2; ++n) ss += dot4(acc[ai][bj][m][n], acc[ai][bj][m][n]);
                        ss += __shfl_xor(ss, 16); ss += __shfl_xor(ss, 32);
                        if (fq == 0) *(float*)((char*)sq + ((size_t)(ai * 128 + m * 16) * 16 + lrow * 16u) * 4) = ss; } }
        } else if (wc < 2) {
            float* kd = KR + rowt * 64; float* sq = SSQ + rowt * 16 + 12 + wc;
#pragma unroll
            for (int ai = 0; ai < 2; ++ai)
#pragma unroll
                for (int m = 0; m < 4; ++m) { const size_t ro = (size_t)(ai * 128 + m * 16);
                    *(f32x4*)((char*)kd + (ro * 64 + lrow * 64u + lcol) * 4) = acc[ai][0][m][0]; *(f32x4*)((char*)kd + (ro * 64 + lrow * 64u + lcol + 4) * 4) = acc[ai][0][m][1];
                    float ss = dot4(acc[ai][0][m][0], acc[ai][0][m][0]) + dot4(acc[ai][0][m][1], acc[ai][0][m][1]);
                    ss += __shfl_xor(ss, 16); ss += __shfl_xor(ss, 32);
                    if (fq == 0) *(float*)((char*)sq + (ro * 16 + lrow * 16u) * 4) = ss; }
        }
    }
};
struct ProbQ {
    static constexpr bool PERM = true; static constexpr int EB = 2;
    int K, lda, ldb; pg8::TileOrder ord; const char* A; const char* Bt; bf16* O;
    __device__ __forceinline__ const char* a_base(const Unit& u) const { return A + (size_t)u.pm * 256 * lda * 2; }
    __device__ __forceinline__ const char* b_base(const Unit& u) const { return Bt + (size_t)u.pn * 256 * ldb * 2; }
    __device__ __forceinline__ void epi(const f32x4 (&acc)[2][2][4][2], const Unit& u, int wr, int wc, int fr, int fq) const {
        unsigned loff = (unsigned)((wr * 64 + fr) * 1536 + wc * 32 + 8 * fq) * 2u; asm volatile("" : "+v"(loff));
        char* base = (char*)(O + (size_t)u.pm * 256 * 1536 + (size_t)u.pn * 256);
#pragma unroll
        for (int ai = 0; ai < 2; ++ai)
#pragma unroll
            for (int m = 0; m < 4; ++m)
#pragma unroll
                for (int bj = 0; bj < 2; ++bj) { const f32x4 v0 = acc[ai][bj][m][0], v1 = acc[ai][bj][m][1];
                    u32x4 w; w.x = pk2(v0[0], v0[1]); w.y = pk2(v0[2], v0[3]); w.z = pk2(v1[0], v1[1]); w.w = pk2(v1[2], v1[3]);
                    *(u32x4*)(base + ((size_t)(ai * 128 + m * 16) * 1536 + bj * 128) * 2 + loff) = w; }
    }
};
struct ProbKV {
    static constexpr bool PERM = true; static constexpr int EB = 2;
    int K, lda, ldb; pg8::TileOrder ord; const char* A; const char* Bt; bf16* Ko; bf16* Vo; const float* SSQ; float* RSTDK; const float* kn; LAS float* part;
    __device__ __forceinline__ const char* a_base(const Unit& u) const { return A + (size_t)u.pm * 256 * lda * 2; }
    __device__ __forceinline__ const char* b_base(const Unit& u) const { return Bt + (size_t)u.pn * 256 * ldb * 2; }
    __device__ __forceinline__ void epi(const f32x4 (&acc)[2][2][4][2], const Unit& u, int wr, int wc, int fr, int fq) const {
        const int h = u.pn; const int rowt = u.pm * 256; const bool lat = rowt < NL;
        const int b = lat ? (rowt >> 12) : ((rowt - NL) >> 8); const int pos0 = lat ? CTXL + (rowt & (SEQ - 1)) : ((rowt - NL) & (CTXL - 1));
        const size_t hrow0 = (size_t)(b * NH + h) * KVLEN + pos0;
        unsigned lrow = (unsigned)(wr * 64 + fr), lcol = (unsigned)(wc * 32 + 8 * fq); asm volatile("" : "+v"(lrow), "+v"(lcol));
        const char* sq = (const char*)(SSQ + (size_t)rowt * 16);
        float sc[2][4], kr2[2][4];
#pragma unroll
        for (int ai = 0; ai < 2; ++ai)
#pragma unroll
            for (int m = 0; m < 4; ++m) { const char* q = sq + ((size_t)(ai * 128 + m * 16) * 16 + lrow * 16u) * 4;
                const f32x4 pk = *(const f32x4*)(q + 32); const f32x2 pr = *(const f32x2*)(q + 48);
                sc[ai][m] = rsqrtf(((pk.x + pk.y) + (pk.z + pk.w)) * (1.f / KVRANK) + EPS); kr2[ai][m] = pr.x + pr.y;
                float ss = 0.f;
#pragma unroll
                for (int n = 0; n < 2; ++n) { const f32x4 y = acc[ai][0][m][n] * sc[ai][m]; ss += dot4(y, y); }
                ss += __shfl_xor(ss, 16); ss += __shfl_xor(ss, 32);
                if (fq == 0) part[(ai * 128 + m * 16 + lrow) * 4 + wc] = ss; }
        asm volatile("s_waitcnt lgkmcnt(0)" ::: "memory"); __builtin_amdgcn_s_barrier(); asm volatile("" ::: "memory");
        const f32x4 g0 = *(const f32x4*)((const char*)kn + lcol * 4), g1 = *(const f32x4*)((const char*)kn + lcol * 4 + 16);
        const unsigned frp = ((unsigned)fr & 3u) | (((unsigned)fr & 8u) >> 1) | (((unsigned)fr & 4u) << 1);
        unsigned voff = (unsigned)wr * 16384u + (4u * (frp >> 3) + (unsigned)wc) * 512u + (frp & 7u) * 64u + (unsigned)fq * 16u; asm volatile("" : "+v"(voff));
        const unsigned koff = (lrow * (unsigned)DQK + lcol) * 2u;
        char* kb = (char*)(Ko + hrow0 * DQK); char* vb = (char*)(Vo + hrow0 * DVH);
#pragma unroll
        for (int ai = 0; ai < 2; ++ai)
#pragma unroll
            for (int m = 0; m < 4; ++m) { const f32x4 pt = *(const LAS f32x4*)(part + (ai * 128 + m * 16 + lrow) * 4);
                const float tot = ((pt.x + pt.y) + (pt.z + pt.w)) + kr2[ai][m]; const float rk = rsqrtf(tot * (1.f / DQK) + EPS); const float f = sc[ai][m] * rk;
                const f32x4 k0 = acc[ai][0][m][0] * f * g0, k1 = acc[ai][0][m][1] * f * g1, v0 = acc[ai][1][m][0] * sc[ai][m], v1 = acc[ai][1][m][1] * sc[ai][m];
                u32x4 w; w.x = pk2(k0[0], k0[1]); w.y = pk2(k0[2], k0[3]); w.z = pk2(k1[0], k1[1]); w.w = pk2(k1[2], k1[3]);
                *(u32x4*)(kb + (size_t)(ai * 128 + m * 16) * DQK * 2 + koff) = w;
                w.x = pk2(v0[0], v0[1]); w.y = pk2(v0[2], v0[3]); w.z = pk2(v1[0], v1[1]); w.w = pk2(v1[2], v1[3]);
                *(u32x4*)(vb + (size_t)(ai * 2) * 16384 + m * 4096 + voff) = w;
                if (wc == 0 && fq == 0) RSTDK[(size_t)(rowt + ai * 128 + m * 16 + lrow) * 8 + h] = rk; }
    }
};
template <int CTRL> __device__ __forceinline__ float dppf(float old, float src) {
    return __builtin_bit_cast(float, __builtin_amdgcn_update_dpp(__builtin_bit_cast(int, old), __builtin_bit_cast(int, src), CTRL, 0xF, 0xF, false));
}
struct ProbGates {
    static constexpr bool PERM = false; static constexpr int EB = 2;
    int K, lda, ldb; pg8::TileOrder ord; const char* U; const char* Bt; char* HP; float* AGG; const float* ba; const float* bx; const float* lam;
    __device__ __forceinline__ const char* a_base(const Unit& u) const { return U + ((size_t)u.pm * 256 * 1024 + (size_t)(u.pn & 7) * 128) * 2; }
    __device__ __forceinline__ const char* b_base(const Unit& u) const { return Bt + (size_t)u.pn * 256 * 128 * 2; }
    template <bool BWD>
    __device__ __forceinline__ void epi_dir(const f32x4 (&acc)[2][2][4][2], const Unit& u, int wr, int wc, int fr, int fq) const {
        const int dir = BWD ? 1 : 0, gblk = u.pn & 7;
        unsigned coff = (unsigned)(wc * 32 + 4 * fq) * 4u;
        unsigned loffu = (unsigned)((wr * 64 + fr) * 1024 + wc * 32 + 4 * fq) * 2u;
        asm volatile("" : "+v"(coff), "+v"(loffu));
        const unsigned loffh = loffu * 2u;
        const size_t ubase = ((size_t)u.pm * 256 * 1024 + (size_t)gblk * 128);
        const char* Ub = U + ubase * 2;
        char* Hb = HP + ((size_t)dir * NR * 1024 + ubase) * 4;
        const char* bap = (const char*)(ba + dir * 1024 + gblk * 128); const char* bxp = (const char*)(bx + dir * 1024 + gblk * 128); const char* lmp = (const char*)(lam + dir * 1024 + gblk * 128);
        const int rowt = u.pm * 256; const int lane = fq * 16 + fr;
        const int bsel = (lane & 48) | (BWD ? 0 : 15);
#pragma unroll
        for (int ai = 0; ai < 2; ++ai) {
            const int r64 = rowt + ai * 128 + wr * 64; const int chunk = r64 < NL ? (r64 >> 12) * NCHUNK + 4 + ((r64 & (SEQ - 1)) >> 6) : ((r64 - NL) >> 8) * NCHUNK + (((r64 - NL) & (CTXL - 1)) >> 6);
#pragma unroll
            for (int n = 0; n < 2; ++n) {
                f32x4 A[4], H[4];
                const f32x4 bav = *(const f32x4*)(bap + n * 64 + coff), bxv = *(const f32x4*)(bxp + n * 64 + coff), lsl = *(const f32x4*)(lmp + n * 64 + coff);
#pragma unroll
                for (int m = 0; m < 4; ++m) {
                    const u32x2 uw = *(const u32x2*)(Ub + ((size_t)(ai * 128 + m * 16) * 1024 + n * 16) * 2 + loffu);
                    const float uv[4] = {bflo(uw.x), bfhi(uw.x), bflo(uw.y), bfhi(uw.y)};
#pragma unroll
                    for (int j = 0; j < 4; ++j) { const float r = sigmoid_fast(acc[ai][0][m][n][j] + bav[j]), ig = sigmoid_fast(acc[ai][1][m][n][j] + bxv[j]);
                        const float la = r * lsl[j]; A[m][j] = __expf(la); H[m][j] = __builtin_amdgcn_sqrtf(one_minus_exp(2.f * la)) * (ig * uv[j]); } }
#pragma unroll
                for (int m = 0; m < 4; ++m)
#pragma unroll
                    for (int j = 0; j < 4; ++j) { float av = A[m][j], hv = H[m][j];
#define SCAN_STEP(D) { const float ap = dppf<(BWD ? 0x100 : 0x110) + D>(1.f, av), hp = dppf<(BWD ? 0x100 : 0x110) + D>(0.f, hv); hv = fmaf(av, hp, hv); av = av * ap; }
                        SCAN_STEP(1) SCAN_STEP(2) SCAN_STEP(4) SCAN_STEP(8)
#undef SCAN_STEP
                        A[m][j] = av; H[m][j] = hv; }
#pragma unroll
                for (int j = 0; j < 4; ++j) { float Ar = 1.f, Hr = 0.f;
#pragma unroll
                    for (int mm = 0; mm < 4; ++mm) { const int m = BWD ? 3 - mm : mm;
                        H[m][j] = fmaf(A[m][j], Hr, H[m][j]); A[m][j] = A[m][j] * Ar;
                        if (mm < 3) { Ar = __shfl(A[m][j], bsel); Hr = __shfl(H[m][j], bsel); } } }
#pragma unroll
                for (int m = 0; m < 4; ++m) { u32x4 w; w.x = pk2(H[m][0], H[m][1]); w.y = pk2(H[m][2], H[m][3]); w.z = pk2(A[m][0], A[m][1]); w.w = pk2(A[m][2], A[m][3]);
                    *(u32x4*)(Hb + ((size_t)(ai * 128 + m * 16) * 1024 + n * 16) * 4 + loffh) = w; }
                constexpr int me = BWD ? 0 : 3;
                if (fr == (BWD ? 0 : 15)) { const size_t o = (size_t)chunk * 1024 + gblk * 128 + n * 16;
                    *(f32x4*)((char*)(AGG + (size_t)(dir * 2 + 0) * NB * NCHUNK * 1024 + o) + coff) = A[me];
                    *(f32x4*)((char*)(AGG + (size_t)(dir * 2 + 1) * NB * NCHUNK * 1024 + o) + coff) = H[me]; }
                asm volatile("" ::: "memory"); __builtin_amdgcn_sched_barrier(0);
            }
        }
    }
    __device__ __forceinline__ void epi(const f32x4 (&acc)[2][2][4][2], const Unit& u, int wr, int wc, int fr, int fq) const {
        if ((u.pn >> 3) == 0) epi_dir<false>(acc, u, wr, wc, fr, fq); else epi_dir<true>(acc, u, wr, wc, fr, fq);
    }
};
struct ProbMixer {
    static constexpr bool PERM = true; static constexpr int EB = 2;
    int K, lda, ldb; pg8::TileOrder ord; const char* A; const char* Bt; const float* xl; const float* xc; const bf16* x1; bf16* XM; const float* modv; int pm0;
    __device__ __forceinline__ const char* a_base(const Unit& u) const { return A + (size_t)(u.pm + pm0) * 256 * 2048 * 2; }
    __device__ __forceinline__ const char* b_base(const Unit& u) const { return Bt + (size_t)u.pn * 256 * 2048 * 2; }
    __device__ __forceinline__ void epi(const f32x4 (&acc)[2][2][4][2], const Unit& u, int wr, int wc, int fr, int fq) const {
        const int rowt = (u.pm + pm0) * 256; const int mb = rowt < NL ? (rowt >> 12) : 4;
        const bool f32in = xl != nullptr;
        const char* xin = f32in ? (const char*)(rowt < NL ? xl + (size_t)rowt * DM : xc + (size_t)(rowt - NL) * DM) + (size_t)u.pn * 1024 : (const char*)(x1 + (size_t)rowt * DM) + (size_t)u.pn * 512;
        const char* g1 = (const char*)(modv + mb * NMODW + 2 * DM) + (size_t)u.pn * 1024;
        char* xo = (char*)(XM + (size_t)rowt * DM) + (size_t)u.pn * 512;
        unsigned lcol = (unsigned)(wc * 32 + 8 * fq), lrow = (unsigned)(wr * 64 + fr); asm volatile("" : "+v"(lcol), "+v"(lrow));
        const unsigned loff4 = (lrow * DM + lcol) * 4u, loff2 = (lrow * DM + lcol) * 2u;
#pragma unroll
        for (int ai = 0; ai < 2; ++ai)
#pragma unroll
            for (int m = 0; m < 4; ++m) { const size_t ro = (size_t)(ai * 128 + m * 16) * DM;
#pragma unroll
                for (int bj = 0; bj < 2; ++bj) { const int cofs = bj * 128;
                    const f32x4 g0 = *(const f32x4*)(g1 + cofs * 4 + lcol * 4), g1v = *(const f32x4*)(g1 + cofs * 4 + lcol * 4 + 16);
                    f32x4 x0, x1v;
                    if (f32in) { x0 = *(const f32x4*)(xin + (ro + cofs) * 4 + loff4); x1v = *(const f32x4*)(xin + (ro + cofs) * 4 + loff4 + 16); }
                    else { const u32x4 w = *(const u32x4*)(xin + (ro + cofs) * 2 + loff2); x0 = (f32x4){bflo(w.x), bfhi(w.x), bflo(w.y), bfhi(w.y)}; x1v = (f32x4){bflo(w.z), bfhi(w.z), bflo(w.w), bfhi(w.w)}; }
                    const f32x4 o0 = x0 + g0 * acc[ai][bj][m][0], o1 = x1v + g1v * acc[ai][bj][m][1];
                    u32x4 ow; ow.x = pk2(o0[0], o0[1]); ow.y = pk2(o0[2], o0[3]); ow.z = pk2(o1[0], o1[1]); ow.w = pk2(o1[2], o1[3]);
                    *(u32x4*)(xo + (ro + cofs) * 2 + loff2) = ow; }
                asm volatile("" ::: "memory"); }
    }
};
struct ProbGateUp {
    static constexpr bool PERM = true; static constexpr int EB = 1;
    int K, lda, ldb; pg8::TileOrder ord; const char* XG; const char* Bt; unsigned char* ACT; int tpe;
    __device__ __forceinline__ const char* a_base(const Unit& u) const { const int e = u.pm / tpe, t = u.pm - e * tpe; return XG + ((size_t)e * EROWS + (size_t)t * 256) * 2048; }
    __device__ __forceinline__ const char* b_base(const Unit& u) const { const int e = u.pm / tpe; return Bt + ((size_t)e * 4096 + (size_t)u.pn * 256) * 2048; }
    __device__ __forceinline__ void epi(const f32x4 (&acc)[2][2][4][2], const Unit& u, int wr, int wc, int fr, int fq) const {
        const int e = u.pm / tpe, t = u.pm - e * tpe;
        char* base = (char*)(ACT + ((size_t)e * EROWS + (size_t)t * 256) * 2048 + (size_t)u.pn * 128);
        unsigned loff = (unsigned)((wr * 64 + fr) * 2048 + wc * 32 + 8 * fq); asm volatile("" : "+v"(loff));
        constexpr float S = 1.f / W8_SCALE;
#pragma unroll
        for (int ai = 0; ai < 2; ++ai)
#pragma unroll
            for (int m = 0; m < 4; ++m) {
                float o[8];
#pragma unroll
                for (int n = 0; n < 2; ++n)
#pragma unroll
                    for (int j = 0; j < 4; ++j) o[n * 4 + j] = silu_fast(acc[ai][0][m][n][j] * S) * (acc[ai][1][m][n][j] * S);
                u32x2 w; w.x = pk4_fp8(o[0], o[1], o[2], o[3]); w.y = pk4_fp8(o[4], o[5], o[6], o[7]);
                *(u32x2*)(base + (size_t)(ai * 128 + m * 16) * 2048 + loff) = w; }
    }
};
struct ProbDown {
    static constexpr bool PERM = true; static constexpr int EB = 1;
    int K, lda, ldb; pg8::TileOrder ord; const char* ACT; const char* Bt; bf16* YE; const float* gatev; int tpe;
    __device__ __forceinline__ const char* a_base(const Unit& u) const { const int e = u.pm / tpe, t = u.pm - e * tpe; return ACT + ((size_t)e * EROWS + (size_t)t * 256) * 2048; }
    __device__ __forceinline__ const char* b_base(const Unit& u) const { const int e = u.pm / tpe; return Bt + ((size_t)e * 2048 + (size_t)u.pn * 256) * 2048; }
    __device__ __forceinline__ void epi(const f32x4 (&acc)[2][2][4][2], const Unit& u, int wr, int wc, int fr, int fq) const {
        const int e = u.pm / tpe, t = u.pm - e * tpe; const size_t rowt = (size_t)e * EROWS + (size_t)t * 256;
        char* base = (char*)(YE + rowt * 2048 + (size_t)u.pn * 256); const char* gp = (const char*)(gatev + rowt);
        unsigned loff = (unsigned)((wr * 64 + fr) * 2048 + wc * 32 + 8 * fq) * 2u, goff = (unsigned)(wr * 64 + fr) * 4u; asm volatile("" : "+v"(loff), "+v"(goff));
#pragma unroll
        for (int ai = 0; ai < 2; ++ai)
#pragma unroll
            for (int m = 0; m < 4; ++m) { const float g = *(const float*)(gp + (ai * 128 + m * 16) * 4 + goff) * (1.f / W8_SCALE);
#pragma unroll
                for (int bj = 0; bj < 2; ++bj) { const f32x4 v0 = acc[ai][bj][m][0] * g, v1 = acc[ai][bj][m][1] * g;
                    u32x4 w; w.x = pk2(v0[0], v0[1]); w.y = pk2(v0[2], v0[3]); w.z = pk2(v1[0], v1[1]); w.w = pk2(v1[2], v1[3]);
                    *(u32x4*)(base + ((size_t)(ai * 128 + m * 16) * 2048 + bj * 128) * 2 + loff) = w; } }
    }
};

namespace att {
constexpr int NW = 8, QBLK = 32, KVBLK = 64;
constexpr float SCALE = 0.07216878364870322f;
constexpr float THR = 8.f;
constexpr int KROWB = 400;
constexpr int SHM_V = KVBLK * DVH * 2, SHM_K = KVBLK * KROWB;
constexpr int NQR = 12;
constexpr int QROWB = (12 - NQR) * 32 + 16;
constexpr int LDS_V = 0, LDS_K = 2 * SHM_V, LDS_WS = 2 * SHM_V + 2 * SHM_K, LDS_QR = LDS_WS + NW * 64 * 4, LDS_TOTAL = LDS_QR + 256 * QROWB;
static_assert(LDS_TOTAL <= LDS_MISC, "attention LDS");
#define SBAR() __builtin_amdgcn_sched_barrier(0)
__device__ __forceinline__ int crow(int r, int hi) { return (r & 3) + 8 * (r >> 2) + 4 * hi; }
__device__ __forceinline__ unsigned cvtpk(float lo, float hi) { unsigned r; asm volatile("v_cvt_pk_bf16_f32 %0, %1, %2" : "=v"(r) : "v"(lo), "v"(hi)); return r; }
constexpr float QSC = SCALE * 1.4426950408889634f;
constexpr float THRL = THR * 1.4426950408889634f;
__device__ __forceinline__ void partialSM(f32x16& p0, f32x16& p1, f32x16& negm, float& l_reg, f32x16* o, LAS float* al_l, int r32, int hi) {
    float ma = fmaxf(fmaxf(p0[0], p0[1]), p0[2]), mb = fmaxf(fmaxf(p1[0], p1[1]), p1[2]);
#pragma unroll
    for (int r = 3; r + 1 < 16; r += 2) { ma = fmaxf(fmaxf(ma, p0[r]), p0[r + 1]); mb = fmaxf(fmaxf(mb, p1[r]), p1[r + 1]); }
    float pmax = fmaxf(fmaxf(ma, mb), fmaxf(p0[15], p1[15]));
    { auto rr = __builtin_amdgcn_permlane32_swap(__float_as_uint(pmax), __float_as_uint(pmax), false, false);
      pmax = fmaxf(__uint_as_float(rr[0]), __uint_as_float(rr[1])); }
    if (__builtin_expect(!__all(pmax <= THRL), 0)) {
        const float d = fmaxf(pmax, 0.f), alpha = __builtin_amdgcn_exp2f(-d), nm = negm[0] - d;
        l_reg *= alpha;
#pragma unroll
        for (int r = 0; r < 16; ++r) { p0[r] -= d; p1[r] -= d; negm[r] = nm; }
        if (hi == 0) al_l[r32] = alpha;
        asm volatile("s_waitcnt lgkmcnt(0)" ::: "memory");
#pragma unroll
        for (int dd = 0; dd < 4; ++dd)
#pragma unroll
            for (int r = 0; r < 16; ++r) o[dd][r] *= al_l[crow(r, hi)];
    }
#pragma unroll
    for (int r = 0; r < 16; ++r) p0[r] = __builtin_amdgcn_exp2f(p0[r]);
}
__device__ __forceinline__ void partialSM_first(f32x16& p0, f32x16& p1, f32x16& negm) {
    float pmax = p0[0];
#pragma unroll
    for (int r = 1; r < 16; ++r) pmax = fmaxf(pmax, p0[r]);
#pragma unroll
    for (int r = 0; r < 16; ++r) pmax = fmaxf(pmax, p1[r]);
    { auto rr = __builtin_amdgcn_permlane32_swap(__float_as_uint(pmax), __float_as_uint(pmax), false, false);
      pmax = fmaxf(__uint_as_float(rr[0]), __uint_as_float(rr[1])); }
#pragma unroll
    for (int r = 0; r < 16; ++r) { p0[r] -= pmax; p1[r] -= pmax; negm[r] = -pmax; }
#pragma unroll
    for (int r = 0; r < 16; ++r) p0[r] = __builtin_amdgcn_exp2f(p0[r]);
}
__device__ __forceinline__ void finishSM(f32x16& p0, f32x16& p1, float& l_reg, bf16x8& pa0, bf16x8& pa1, bf16x8& pa2, bf16x8& pa3) {
#pragma unroll
    for (int r = 0; r < 16; ++r) p1[r] = __builtin_amdgcn_exp2f(p1[r]);
    float ps = 0;
#pragma unroll
    for (int r = 0; r < 16; ++r) ps += p0[r];
#pragma unroll
    for (int r = 0; r < 16; ++r) ps += p1[r];
    { auto rr = __builtin_amdgcn_permlane32_swap(__float_as_uint(ps), __float_as_uint(ps), false, false);
      ps = __uint_as_float(rr[0]) + __uint_as_float(rr[1]); }
    l_reg += ps;
#define PK4(P, BASE, OUT) do { unsigned a0 = cvtpk(P[BASE + 0], P[BASE + 1]), a1 = cvtpk(P[BASE + 2], P[BASE + 3]);   \
    unsigned b0 = cvtpk(P[BASE + 4], P[BASE + 5]), b1 = cvtpk(P[BASE + 6], P[BASE + 7]);                              \
    auto r0 = __builtin_amdgcn_permlane32_swap(a0, b0, false, false); auto r1 = __builtin_amdgcn_permlane32_swap(a1, b1, false, false); \
    u32x4 w = {r0[0], r1[0], r0[1], r1[1]}; OUT = *reinterpret_cast<bf16x8*>(&w); } while (0)
    PK4(p0, 0, pa0); PK4(p0, 8, pa1); PK4(p1, 0, pa2); PK4(p1, 8, pa3);
#undef PK4
}
__device__ __forceinline__ void qkt(f32x16& p0, f32x16& p1, const LAS char* Kl, const bf16x8* qr, const LAS char* Ql, const f32x16& init) {
#pragma unroll
    for (int d0 = 0; d0 < 12; ++d0) {
        const bf16x8 b0 = *reinterpret_cast<const LAS bf16x8*>(Kl + d0 * 32);
        const bf16x8 b1 = *reinterpret_cast<const LAS bf16x8*>(Kl + 32 * KROWB + d0 * 32);
        const bf16x8 q = d0 < NQR ? qr[d0 < NQR ? d0 : 0] : *reinterpret_cast<const LAS bf16x8*>(Ql + (d0 - NQR) * 32);
        p0 = __builtin_amdgcn_mfma_f32_32x32x16_bf16(b0, q, d0 == 0 ? init : p0, 0, 0, 0);
        p1 = __builtin_amdgcn_mfma_f32_32x32x16_bf16(b1, q, d0 == 0 ? init : p1, 0, 0, 0); }
}
__device__ __forceinline__ int v_st(int k, int c) { const int kk = (k & ~0xC) | ((k & 4) << 1) | ((k & 8) >> 1); return ((kk >> 3) * 4 + (c >> 5)) * 512 + ((kk & 7) * 32 + (c & 31)) * 2; }
__device__ __forceinline__ int v_rd_base(int lane) { return ((lane & 3) << 3) | (((lane >> 2) & 3) << 6) | (((lane >> 4) & 1) << 5) | (((lane >> 5) & 1) << 8); }
constexpr int v_rd_off(int d0, int ks, int half) { return d0 * 512 + ks * 4096 + half * 2048; }
template <int OFF> __device__ __forceinline__ s16x4 tr_read(int vb) {
    s16x4 r; asm volatile("ds_read_b64_tr_b16 %0, %1 offset:%2" : "=&v"(r) : "v"(vb), "i"(OFF) : "memory"); return r;
}
template <int D0> __device__ __forceinline__ void pv_one(f32x16& od, int vb, bf16x8 pa0, bf16x8 pa1, bf16x8 pa2, bf16x8 pa3) {
    const s16x4 l0 = tr_read<v_rd_off(D0, 0, 0)>(vb), h0 = tr_read<v_rd_off(D0, 0, 1)>(vb), l1 = tr_read<v_rd_off(D0, 1, 0)>(vb), h1 = tr_read<v_rd_off(D0, 1, 1)>(vb);
    const s16x4 l2 = tr_read<v_rd_off(D0, 2, 0)>(vb), h2 = tr_read<v_rd_off(D0, 2, 1)>(vb), l3 = tr_read<v_rd_off(D0, 3, 0)>(vb), h3 = tr_read<v_rd_off(D0, 3, 1)>(vb);
    asm volatile("s_waitcnt lgkmcnt(0)" ::: "memory"); SBAR();
#define PK(L, H) (bf16x8){L[0], L[1], L[2], L[3], H[0], H[1], H[2], H[3]}
    od = __builtin_amdgcn_mfma_f32_32x32x16_bf16(pa0, PK(l0, h0), od, 0, 0, 0);
    od = __builtin_amdgcn_mfma_f32_32x32x16_bf16(pa1, PK(l1, h1), od, 0, 0, 0);
    od = __builtin_amdgcn_mfma_f32_32x32x16_bf16(pa2, PK(l2, h2), od, 0, 0, 0);
    od = __builtin_amdgcn_mfma_f32_32x32x16_bf16(pa3, PK(l3, h3), od, 0, 0, 0);
#undef PK
}
__device__ __forceinline__ void pv_d0(f32x16* o, int vb, bf16x8 pa0, bf16x8 pa1, bf16x8 pa2, bf16x8 pa3) {
    pv_one<0>(o[0], vb, pa0, pa1, pa2, pa3); pv_one<1>(o[1], vb, pa0, pa1, pa2, pa3); pv_one<2>(o[2], vb, pa0, pa1, pa2, pa3); pv_one<3>(o[3], vb, pa0, pa1, pa2, pa3);
}
__device__ __forceinline__ void attn_unit(const bf16* __restrict__ Qraw, const float* __restrict__ ssq, const float* __restrict__ qn, int t0, const bf16* __restrict__ Kh, const bf16* __restrict__ Vh, bf16* __restrict__ Ob, int seq, LAS char* lds, int tid) {
    const int wid = __builtin_amdgcn_readfirstlane(tid >> 6), lane = tid & 63, r32 = lane & 31, hi = lane >> 5;
    LAS char* V_lds = lds + LDS_V; LAS char* K_lds = lds + LDS_K;
    LAS float* ws = (LAS float*)(lds + LDS_WS) + wid * 64; LAS float* li_l = ws; LAS float* al_l = ws + 32;
    float l_reg = 0; f32x16 o[4] = {}; bf16x8 qr[NQR];
    const char* Qw = (const char*)Qraw + (size_t)(wid * QBLK) * 1536 * 2; const unsigned qoff = (unsigned)(r32 * 1536 + hi * 8) * 2u;
    LAS char* Ql = lds + LDS_QR + (wid * QBLK + r32) * QROWB + hi * 16;
    {
        bf16x8 raw[12];
        unsigned gq = (unsigned)hi * 32u; asm volatile("" : "+v"(gq));
        const char* qnb = (const char*)qn;
#pragma unroll
        for (int d0 = 0; d0 < 12; ++d0) raw[d0] = *reinterpret_cast<const bf16x8*>(Qw + d0 * 32 + qoff);
        const float* sp = ssq + (size_t)(wid * QBLK + r32) * 16; const f32x4 p0 = *(const f32x4*)sp, p1 = *(const f32x4*)(sp + 4);
        const float sq = rsqrtf((((p0.x + p0.y) + (p0.z + p0.w)) + ((p1.x + p1.y) + (p1.z + p1.w))) * (1.f / QRANK) + EPS);
        float ss = 0.f;
#pragma unroll
        for (int d0 = 0; d0 < 12; ++d0)
#pragma unroll
            for (int e = 0; e < 8; ++e) { const float y = bf2f((unsigned short)raw[d0][e]) * sq; ss = fmaf(y, y, ss); }
        ss += __shfl_xor(ss, 32);
        const float f = sq * rsqrtf(ss * (1.f / DQK) + EPS) * QSC;
#pragma unroll
        for (int d0 = 0; d0 < 8; ++d0) { const f32x4 g0 = *(const f32x4*)(qnb + d0 * 64 + gq), g1 = *(const f32x4*)(qnb + d0 * 64 + 16 + gq);
            u32x4 w; w.x = pk2(bf2f((unsigned short)raw[d0][0]) * f * g0.x, bf2f((unsigned short)raw[d0][1]) * f * g0.y); w.y = pk2(bf2f((unsigned short)raw[d0][2]) * f * g0.z, bf2f((unsigned short)raw[d0][3]) * f * g0.w);
            w.z = pk2(bf2f((unsigned short)raw[d0][4]) * f * g1.x, bf2f((unsigned short)raw[d0][5]) * f * g1.y); w.w = pk2(bf2f((unsigned short)raw[d0][6]) * f * g1.z, bf2f((unsigned short)raw[d0][7]) * f * g1.w);
            if (d0 < NQR) qr[d0 < NQR ? d0 : 0] = __builtin_bit_cast(bf16x8, w); else *reinterpret_cast<LAS bf16x8*>(Ql + (d0 - NQR) * 32) = __builtin_bit_cast(bf16x8, w); }
        const int t = t0 + wid * QBLK + r32; const float pr = (float)(t >> 6), pc = (float)(t & 63);
#pragma unroll
        for (int ax = 0; ax < 2; ++ax) {
            float x1[8], x2[8];
            const f32x4 ga0 = *(const f32x4*)(qnb + (128 + 32 * ax) * 4 + gq), ga1 = *(const f32x4*)(qnb + (128 + 32 * ax) * 4 + 16 + gq), gb0 = *(const f32x4*)(qnb + (144 + 32 * ax) * 4 + gq), gb1 = *(const f32x4*)(qnb + (144 + 32 * ax) * 4 + 16 + gq);
            const float ga[8] = {ga0.x, ga0.y, ga0.z, ga0.w, ga1.x, ga1.y, ga1.z, ga1.w}, gb[8] = {gb0.x, gb0.y, gb0.z, gb0.w, gb1.x, gb1.y, gb1.z, gb1.w};
#pragma unroll
            for (int e = 0; e < 8; ++e) { x1[e] = bf2f((unsigned short)raw[8 + 2 * ax][e]) * f * ga[e]; x2[e] = bf2f((unsigned short)raw[9 + 2 * ax][e]) * f * gb[e]; }
            if (t0 >= 0) { const float p = ax ? pc : pr;
#pragma unroll
                for (int e = 0; e < 8; ++e) { const float inv = __builtin_amdgcn_exp2f(-(float)((gq >> 2) + e) * (13.287712379549449f / 16.f)); float sn, cs; __sincosf(p * inv, &sn, &cs);
                    const float y1 = x1[e] * cs - x2[e] * sn, y2 = x2[e] * cs + x1[e] * sn; x1[e] = y1; x2[e] = y2; } }
            u32x4 w; w.x = pk2(x1[0], x1[1]); w.y = pk2(x1[2], x1[3]); w.z = pk2(x1[4], x1[5]); w.w = pk2(x1[6], x1[7]);
            if (8 + 2 * ax < NQR) qr[8 + 2 * ax < NQR ? 8 + 2 * ax : 0] = __builtin_bit_cast(bf16x8, w); else *reinterpret_cast<LAS bf16x8*>(Ql + (8 + 2 * ax >= NQR ? 8 - NQR + 2 * ax : 0) * 32) = __builtin_bit_cast(bf16x8, w);
            w.x = pk2(x2[0], x2[1]); w.y = pk2(x2[2], x2[3]); w.z = pk2(x2[4], x2[5]); w.w = pk2(x2[6], x2[7]);
            if (9 + 2 * ax < NQR) qr[9 + 2 * ax < NQR ? 9 + 2 * ax : 0] = __builtin_bit_cast(bf16x8, w); else *reinterpret_cast<LAS bf16x8*>(Ql + (9 + 2 * ax >= NQR ? 9 - NQR + 2 * ax : 0) * 32) = __builtin_bit_cast(bf16x8, w); }
    }
#define KOFS(j_) ({ const int p_ = 64 * (wid + 8 * (j_)) + lane, row_ = p_ / 25; int cc_ = p_ - row_ * 25; if (cc_ == 24) cc_ = 0; (unsigned)((row_ < 64 ? row_ : 0) * (DQK * 2) + cc_ * 16); })
    const unsigned ko0 = KOFS(0), ko1 = KOFS(1), ko2 = KOFS(2), ko3 = KOFS(3);
#undef KOFS
    const unsigned vo0 = (unsigned)(wid * 1024 + lane * 16);
    const int vb0 = (int)(unsigned)(size_t)V_lds + v_rd_base(lane);
    const LAS char* Kl0 = K_lds + r32 * KROWB + hi * 16;
#define DMA_V(k0, b) do { const char* vb_ = (const char*)Vh + (size_t)(k0) * (DVH * 2); LAS char* ld_ = V_lds + (b) * SHM_V + wid * 1024; \
    unsigned a0_ = vo0; asm volatile("" : "+v"(a0_)); \
    __builtin_amdgcn_global_load_lds((const unsigned*)(vb_ + a0_), (LAS unsigned*)(ld_), 16, 0, 0); __builtin_amdgcn_global_load_lds((const unsigned*)(vb_ + 8192 + a0_), (LAS unsigned*)(ld_ + 8192), 16, 0, 0); } while (0)
#define DMA_K(k0, b) do { const char* kb_ = (const char*)Kh + (size_t)(k0) * (DQK * 2); LAS char* ld_ = K_lds + (b) * SHM_K + wid * 1024; \
    unsigned a0_ = ko0, a1_ = ko1, a2_ = ko2; asm volatile("" : "+v"(a0_), "+v"(a1_), "+v"(a2_));     \
    __builtin_amdgcn_global_load_lds((const unsigned*)(kb_ + a0_), (LAS unsigned*)(ld_), 16, 0, 0); __builtin_amdgcn_global_load_lds((const unsigned*)(kb_ + a1_), (LAS unsigned*)(ld_ + 8192), 16, 0, 0); \
    __builtin_amdgcn_global_load_lds((const unsigned*)(kb_ + a2_), (LAS unsigned*)(ld_ + 16384), 16, 0, 0); \
    if (wid == 0) { unsigned a3_ = ko3; asm volatile("" : "+v"(a3_)); __builtin_amdgcn_global_load_lds((const unsigned*)(kb_ + a3_), (LAS unsigned*)(ld_ + 24576), 16, 0, 0); } } while (0)
#define KWAIT_BAR() do { asm volatile("s_waitcnt vmcnt(0)" ::: "memory"); __syncthreads(); } while (0)
#define SWAIT() asm volatile("s_waitcnt vmcnt(0)" ::: "memory")
#define RESC(a) do { if (__any((a) < 1.f)) { if (hi == 0) al_l[r32] = (a); asm volatile("s_waitcnt lgkmcnt(0)" ::: "memory"); \
    _Pragma("unroll") for (int d = 0; d < 4; ++d) _Pragma("unroll") for (int r = 0; r < 16; ++r) o[d][r] *= al_l[crow(r, hi)]; } } while (0)
    f32x16 pA0, pA1, pB0, pB1, negm; bf16x8 pa0, pa1, pa2, pa3; const int NT = seq / KVBLK;
    DMA_K(0, 0); DMA_K(KVBLK, 1); DMA_V(0, 0); KWAIT_BAR();
    qkt(pA0, pA1, Kl0, qr, Ql, f32x16{}); partialSM_first(pA0, pA1, negm);
    __syncthreads();
    for (int h = 1; h + 1 < NT; h += 2) {
        DMA_V(h * KVBLK, 1); DMA_K((h + 1) * KVBLK, 0);
        SBAR(); qkt(pB0, pB1, Kl0 + SHM_K, qr, Ql, negm);
        finishSM(pA0, pA1, l_reg, pa0, pa1, pa2, pa3); SBAR();
        pv_d0(o, vb0, pa0, pa1, pa2, pa3); partialSM(pB0, pB1, negm, l_reg, o, al_l, r32, hi);
        KWAIT_BAR();
        DMA_V((h + 1) * KVBLK, 0); DMA_K((h + 2) * KVBLK, 1);
        SBAR(); qkt(pA0, pA1, Kl0, qr, Ql, negm);
        finishSM(pB0, pB1, l_reg, pa0, pa1, pa2, pa3); SBAR();
        pv_d0(o, vb0 + SHM_V, pa0, pa1, pa2, pa3); partialSM(pA0, pA1, negm, l_reg, o, al_l, r32, hi);
        KWAIT_BAR();
    }
    DMA_V((NT - 1) * KVBLK, 1);
    SBAR(); qkt(pB0, pB1, Kl0 + SHM_K, qr, Ql, negm);
    finishSM(pA0, pA1, l_reg, pa0, pa1, pa2, pa3); SBAR();
    pv_d0(o, vb0, pa0, pa1, pa2, pa3); partialSM(pB0, pB1, negm, l_reg, o, al_l, r32, hi);
    KWAIT_BAR();
    finishSM(pB0, pB1, l_reg, pa0, pa1, pa2, pa3); SBAR();
    pv_d0(o, vb0 + SHM_V, pa0, pa1, pa2, pa3);
    if (hi == 0) li_l[r32] = l_reg; asm volatile("s_waitcnt lgkmcnt(0)" ::: "memory");
    float rli[16];
#pragma unroll
    for (int r = 0; r < 16; ++r) rli[r] = __builtin_amdgcn_rcpf(li_l[crow(r, hi)]);
    char* Ow = (char*)Ob + (size_t)(wid * QBLK) * DM * 2; const unsigned ooff = (unsigned)(4 * hi * DM + r32) * 2u;
#pragma unroll
    for (int r = 0; r < 16; ++r) {
#pragma unroll
        for (int d0 = 0; d0 < 4; ++d0) *(bf16*)(Ow + (((r & 3) + 8 * (r >> 2)) * DM + d0 * 32) * 2 + ooff) = (bf16)f2bf(o[d0][r] * rli[r]); }
    __syncthreads();
#undef DMA_K
#undef KWAIT_BAR
#undef DMA_V
#undef SWAIT
#undef RESC
}
}

#ifndef DUP_MASK
#define DUP_MASK 0
#endif
#define NREP(j) (1 + ((DUP_MASK >> (j)) & 1))
struct Ctx { LAS unsigned char* lds; int tid, lane, wave, bid, G; };
#define WSP(T, off) ((T*)(GAS T*)(wsb + (off)))
#define INP(i) ((const float*)(const GAS float*)a.in[i])
#define WSW(T, off, l) WSP(T, WS_WSET + (size_t)(l) * WSET_STRIDE + (off))
#define PHASE_BEGIN() Ctx c = c0; { int t_ = c0.tid; asm volatile("" : "+v"(t_)); c.tid = t_; c.lane = t_ & 63; c.wave = __builtin_amdgcn_readfirstlane(t_ >> 6); } \
    GAS unsigned char* wsb = (GAS unsigned char*)a.ws; asm volatile("" : "+s"(wsb));

__device__ __forceinline__ void convert_tile(const Args& a, GAS unsigned char* wsb, int l, int t, LAS float* scr, int lane);
__device__ __forceinline__ void convert_misc(const Args& a, GAS unsigned char* wsb, int l, int gt, int NGT);
__device__ __forceinline__ void mod_items(const Args& a, const Ctx& c0, int l) {
    PHASE_BEGIN();
    __syncthreads();
    LAS float* sc = (LAS float*)c.lds;
    LAS float* red = (LAS float*)(c.lds + 40960);
    for (int i = c.tid; i < 5 * DM; i += 512) { const int r = i >> 11, k = i & 2047; const float v = r < 4 ? INP(1)[r * DM + k] : INP(3)[k]; sc[i] = silu_(v); }
    __syncthreads();
    const int cl = c.tid & 15, kg = c.tid >> 4;
    float* modv = WSP(float, WS_MODV);
    for (int cb = c.bid; cb < 192; cb += c.G) {
        const float* w = INP(4) + (size_t)l * DM * NMODW + cb * 64 + cl * 4;
        f32x4 acc[5];
#pragma unroll
        for (int r = 0; r < 5; ++r) acc[r] = (f32x4){0.f, 0.f, 0.f, 0.f};
#pragma unroll 4
        for (int k = kg; k < DM; k += 32) { const f32x4 wv = *(const f32x4*)(w + (size_t)k * NMODW);
#pragma unroll
            for (int r = 0; r < 5; ++r) acc[r] += sc[r * DM + k] * wv; }
#pragma unroll
        for (int r = 0; r < 5; ++r) *(LAS f32x4*)(red + (kg * 5 + r) * 64 + cl * 4) = acc[r];
        __syncthreads();
        if (c.tid < 320) { const int r = c.tid >> 6, cc = c.tid & 63; float s = 0.f;
            for (int g = 0; g < 32; ++g) s += red[(g * 5 + r) * 64 + cc];
            modv[(size_t)(l * 5 + r) * NMODW + cb * 64 + cc] = s + INP(5)[(size_t)l * NMODW + cb * 64 + cc]; }
        __syncthreads();
    }
}
__device__ __forceinline__ void phase_mod(const Args& a, const Ctx& c0) {
    { PHASE_BEGIN();
      LAS float* scr = (LAS float*)(c.lds + c.wave * 16640); for (int t = c.bid * 8 + c.wave; t < T_SMALL; t += c.G * 8) convert_tile(a, wsb, 0, t, scr, c.lane);
      convert_misc(a, wsb, 0, c.bid * 512 + c.tid, c.G * 512); convert_misc(a, wsb, 1, c.bid * 512 + c.tid, c.G * 512); }
    mod_items(a, c0, 0);
}

__device__ __forceinline__ void tr_item(const float* W, int ldw, int k0, int n0, bf16* WT, int ldt, int drow0, LAS float* scr, int lane, const float* kscale = nullptr) {
    const float* src = W + (size_t)(k0 + (lane >> 4)) * ldw + n0 + (lane & 15) * 4;
    f32x4 v[16];
#pragma unroll
    for (int i = 0; i < 16; ++i) v[i] = __builtin_nontemporal_load((const f32x4*)(src + (size_t)(4 * i) * ldw));
    LAS float* wp = scr + (lane >> 4) * 65 + (lane & 15) * 4;
#pragma unroll
    for (int i = 0; i < 16; ++i) { LAS float* q = wp + (4 * i) * 65; const float ks = kscale ? kscale[k0 + 4 * i + (lane >> 4)] : 1.f; q[0] = v[i].x * ks; q[1] = v[i].y * ks; q[2] = v[i].z * ks; q[3] = v[i].w * ks; }
    asm volatile("s_waitcnt lgkmcnt(0)" ::: "memory");
    const int kc = lane & 7;
#pragma unroll
    for (int j = 0; j < 8; ++j) { const int n = (lane >> 3) + 8 * j; const LAS float* sp = scr + (8 * kc) * 65 + n;
        u32x4 o; o.x = pk2(sp[0 * 65], sp[1 * 65]); o.y = pk2(sp[2 * 65], sp[3 * 65]); o.z = pk2(sp[4 * 65], sp[5 * 65]); o.w = pk2(sp[6 * 65], sp[7 * 65]);
        __builtin_nontemporal_store(o, (u32x4*)(WT + (size_t)(drow0 + n) * ldt + k0 + 8 * kc)); }
    asm volatile("s_waitcnt lgkmcnt(0)" ::: "memory");
}
__device__ __forceinline__ void tr_item8(const float* W, int ldw, int k0, int n0, unsigned char* WT, int ldt, int drow0, LAS float* scr, int lane) {
    const float* src = W + (size_t)(k0 + (lane >> 4)) * ldw + n0 + (lane & 15) * 4;
    f32x4 v[16];
#pragma unroll
    for (int i = 0; i < 16; ++i) v[i] = __builtin_nontemporal_load((const f32x4*)(src + (size_t)(4 * i) * ldw));
    LAS float* wp = scr + (lane >> 4) * 65 + (lane & 15) * 4;
#pragma unroll
    for (int i = 0; i < 16; ++i) { LAS float* q = wp + (4 * i) * 65; q[0] = v[i].x * W8_SCALE; q[1] = v[i].y * W8_SCALE; q[2] = v[i].z * W8_SCALE; q[3] = v[i].w * W8_SCALE; }
    asm volatile("s_waitcnt lgkmcnt(0)" ::: "memory");
    const int kc = lane & 7;
#pragma unroll
    for (int j = 0; j < 8; ++j) { const int n = (lane >> 3) + 8 * j; const LAS float* sp = scr + (8 * kc) * 65 + n;
        u32x2 o; o.x = pk4_fp8(sp[0 * 65], sp[1 * 65], sp[2 * 65], sp[3 * 65]); o.y = pk4_fp8(sp[4 * 65], sp[5 * 65], sp[6 * 65], sp[7 * 65]);
        __builtin_nontemporal_store(o, (u32x2*)(WT + (size_t)(drow0 + n) * ldt + k0 + 8 * kc)); }
    asm volatile("s_waitcnt lgkmcnt(0)" ::: "memory");
}
__device__ __forceinline__ void norm_mod_row(const float* xrow, const float* g, const float* sh, const float* scl, bf16* orow, int lane) {
    f32x4 v[8], gs[8], sv[8]; float s = 0.f;
#pragma unroll
    for (int j = 0; j < 8; ++j) v[j] = ((const f32x4*)xrow)[lane + 64 * j];
#pragma unroll
    for (int j = 0; j < 8; ++j) { const int idx = (lane + 64 * j) * 4; gs[j] = *(const f32x4*)(g + idx) * (1.f + *(const f32x4*)(scl + idx)); sv[j] = *(const f32x4*)(sh + idx); }
#pragma unroll
    for (int j = 0; j < 8; ++j) s += dot4(v[j], v[j]);
    const float rstd = rsqrtf(wave_sum(s) * (1.f / DM) + EPS);
#pragma unroll
    for (int j = 0; j < 8; ++j) { const int idx = (lane + 64 * j) * 4; const f32x4 o = (v[j] * rstd) * gs[j] + sv[j];
        u32x2 w; w.x = pk2(o.x, o.y); w.y = pk2(o.z, o.w); *(u32x2*)(orow + idx) = w; }
}
__device__ __forceinline__ const float* xin_row(const Args& a, GAS unsigned char* wsb, int l, int row) {
    if (l == 0) return row < NL ? INP(0) + (size_t)row * DM : INP(2) + (size_t)(row - NL) * DM;
    return WSP(const float, WS_X1) + (size_t)row * DM;
}
__device__ __forceinline__ void convert_tile(const Args& a, GAS unsigned char* wsb, int l, int t, LAS float* scr, int lane) {
    constexpr int I_IN = 32 * 45, I_UQ = 8 * 24, I_UKV = 4 * 32, I_OUT = 32 * 32, I_EXP = 32 * 32;
    int r = t;
    if (r < I_IN) { const int kb = r / 45, nb = r - kb * 45; tr_item(INP(7) + (size_t)l * DM * INW, INW, kb * 64, nb * 64, WSW(bf16, W_IN, l), DM, nb * 64, scr, lane); return; }
    r -= I_IN;
    if (r < I_UQ) { const int kb = r / 24, nb = r - kb * 24; tr_item(INP(16) + (size_t)l * QRANK * 1536, 1536, kb * 64, nb * 64, WSW(bf16, W_UQ, l), QRANK, nb * 64, scr, lane, INP(15) + (size_t)l * QRANK); return; }
    r -= I_UQ;
    if (r < I_UKV) { const int kb = r / 32, nb = r - kb * 32; tr_item(INP(18) + (size_t)l * KVRANK * 2048, 2048, kb * 64, nb * 64, WSW(bf16, W_UKV, l), KVRANK, nb * 64, scr, lane, INP(17) + (size_t)l * KVRANK); return; }
    r -= I_UKV;
    if (r < I_OUT) { const int kb = r / 32, nb = r - kb * 32; tr_item(INP(21) + (size_t)l * DM * DM, DM, kb * 64, nb * 64, WSW(bf16, W_OUT, l), DM, nb * 64, scr, lane); return; }
    r -= I_OUT;
    const int which = r / (NE * I_EXP); r -= which * (NE * I_EXP);
    const int e = r / I_EXP; r -= e * I_EXP; const int kb = r / 32, nb = r - kb * 32, n0 = nb * 64;
    const float* W = INP(24 + which) + ((size_t)l * NE + e) * DM * DM;
    if (which == 0)      tr_item8(W, DM, kb * 64, n0, WSW(unsigned char, W_GU, l), DM, e * 4096 + (n0 >> 7) * 256 + (n0 & 127), scr, lane);
    else if (which == 1) tr_item8(W, DM, kb * 64, n0, WSW(unsigned char, W_GU, l), DM, e * 4096 + (n0 >> 7) * 256 + 128 + (n0 & 127), scr, lane);
    else                 tr_item8(W, DM, kb * 64, n0, WSW(unsigned char, W_DN, l), DM, e * 2048 + n0, scr, lane);
}
__device__ __forceinline__ void convert_misc(const Args& a, GAS unsigned char* wsb, int l, int gt, int NGT) {
    { u32x4* z = (u32x4*)(WSW(bf16, W_IN, l) + (size_t)INW * DM); for (int i = gt; i < (INWP - INW) * DM / 8; i += NGT) z[i] = (u32x4){0u, 0u, 0u, 0u}; }
    { bf16* wg = WSW(bf16, W_GT, l);
      for (int i = gt; i < 4096 * 128; i += NGT) { const int ng = i >> 7, kk = i & 127, pn = ng >> 8, n = ng & 255, dir = pn >> 3, gblk = pn & 7, j = n & 127;
          const float* src = (n < 128 ? INP(10) : INP(12)) + ((size_t)((l * 2 + dir) * 8 + gblk)) * 128 * 128;
          wg[i] = (bf16)f2bf(src[kk * 128 + j]); } }
    { float* lsl = WSP(float, WS_LSL) + (size_t)l * 2 * RW; const float* lm = INP(14) + (size_t)l * 2 * RW; for (int i = gt; i < 2 * RW; i += NGT) lsl[i] = -8.f * log1pf(expf(-lm[i])); }
}
__device__ __forceinline__ void bg_fill(const Args& a, const Ctx& c0, int site, int must) {
    PHASE_BEGIN();
    unsigned* ctl = WSP(unsigned, WS_CTL); unsigned* head = ctl + CW_QHEAD; unsigned* done = ctl + CW_QDONE + 64 * site;
    volatile LAS unsigned* bc = (volatile LAS unsigned*)(c.lds + LDS_MISC + 64);
    LAS float* scr = (LAS float*)(c.lds + c.wave * 16640);
    __syncthreads();
    if (c.tid == 0) (void)__hip_atomic_fetch_add(done, 1u, __ATOMIC_RELAXED, __HIP_MEMORY_SCOPE_AGENT);
    for (;;) {
        if (c.tid == 0) { unsigned s = 0xffffffffu;
            const unsigned h = __hip_atomic_load(head, __ATOMIC_RELAXED, __HIP_MEMORY_SCOPE_AGENT);
            bool go = h < (unsigned)must;
            if (!go && h < (unsigned)BG_STEPS) go = __hip_atomic_load(done, __ATOMIC_RELAXED, __HIP_MEMORY_SCOPE_AGENT) + 8u < (unsigned)c.G;
            if (go) { s = __hip_atomic_fetch_add(head, 1u, __ATOMIC_RELAXED, __HIP_MEMORY_SCOPE_AGENT); if (s >= (unsigned)BG_STEPS) s = 0xffffffffu; }
            bc[0] = s; }
        __syncthreads();
        const unsigned s = bc[0];
        if (s == 0xffffffffu) break;
        const int g = (int)s * 8 + c.wave;
        if (g < T_MOE) convert_tile(a, wsb, 0, T_SMALL + g, scr, c.lane); else convert_tile(a, wsb, 1, g - T_MOE, scr, c.lane);
        __syncthreads();
    }
}
__device__ __forceinline__ void bg_take(const Args& a, const Ctx& c0, int n) {
    PHASE_BEGIN();
    unsigned* head = WSP(unsigned, WS_CTL) + CW_QHEAD;
    volatile LAS unsigned* bc = (volatile LAS unsigned*)(c.lds + LDS_MISC + 64);
    LAS float* scr = (LAS float*)(c.lds + c.wave * 16640);
    __syncthreads();
    for (int i = 0; i < n; ++i) {
        if (c.tid == 0) { unsigned s = __hip_atomic_fetch_add(head, 1u, __ATOMIC_RELAXED, __HIP_MEMORY_SCOPE_AGENT); if (s >= (unsigned)BG_STEPS) s = 0xffffffffu; bc[0] = s; }
        __syncthreads();
        const unsigned s = bc[0];
        if (s == 0xffffffffu) break;
        const int g = (int)s * 8 + c.wave;
        if (g < T_MOE) convert_tile(a, wsb, 0, T_SMALL + g, scr, c.lane); else convert_tile(a, wsb, 1, g - T_MOE, scr, c.lane);
        __syncthreads();
    }
    __syncthreads();
}
__device__ __forceinline__ void phase_l0(const Args& a, const Ctx& c0, int l) {
    PHASE_BEGIN();
    const int gw = c.bid * 8 + c.wave, NGW = c.G * 8;
    const float* modv = WSP(const float, WS_MODV);
    for (int row = gw; row < NR; row += NGW) { const int mb = row < NL ? (row >> 12) : 4; const float* mv = modv + (size_t)mb * NMODW;
        norm_mod_row(xin_row(a, wsb, 0, row), INP(6), mv, mv + DM, WSP(bf16, WS_H) + (size_t)row * DM, c.lane); }
}

__device__ __forceinline__ void phase_conv(const Args& a, const Ctx& c0, int l) {
    PHASE_BEGIN();
    const bf16* XR = WSP(const bf16, WS_XR); bf16* U = WSP(bf16, WS_U);
    const float* cw = INP(8) + (size_t)l * 4 * RW; const float* cb = INP(9) + (size_t)l * RW;
    const int ch = (c.tid & 127) * 8, rg = c.tid >> 7;
    float w[4][8], bias[8];
#pragma unroll
    for (int k = 0; k < 4; ++k) { const f32x4 w0 = *(const f32x4*)(cw + k * RW + ch), w1 = *(const f32x4*)(cw + k * RW + ch + 4);
        w[k][0] = w0.x; w[k][1] = w0.y; w[k][2] = w0.z; w[k][3] = w0.w; w[k][4] = w1.x; w[k][5] = w1.y; w[k][6] = w1.z; w[k][7] = w1.w; }
    { const f32x4 b0 = *(const f32x4*)(cb + ch), b1 = *(const f32x4*)(cb + ch + 4); bias[0] = b0.x; bias[1] = b0.y; bias[2] = b0.z; bias[3] = b0.w; bias[4] = b1.x; bias[5] = b1.y; bias[6] = b1.z; bias[7] = b1.w; }
    for (int it = c.bid; it < NB * NCHUNK; it += c.G) {
        const int b = it / NCHUNK, cc = it - b * NCHUNK; const bool isc = cc < 4;
        const int seg0 = isc ? NL + b * CTXL : b * SEQ, T = isc ? CTXL : SEQ, t0 = (isc ? cc : cc - 4) * 64 + rg * 16;
        u32x4 x[19];
#pragma unroll
        for (int i = 0; i < 19; ++i) { const int t = t0 - 2 + i; x[i] = (t >= 0 && t < T) ? *(const u32x4*)(XR + (size_t)(seg0 + t) * RW + ch) : (u32x4){0u, 0u, 0u, 0u}; }
#pragma unroll
        for (int r = 0; r < 16; ++r) { float o[8];
#pragma unroll
            for (int e = 0; e < 8; ++e) o[e] = bias[e];
#pragma unroll
            for (int k = 0; k < 4; ++k) { const u32x4 xv = x[r + k];
                o[0] = fmaf(bflo(xv.x), w[k][0], o[0]); o[1] = fmaf(bfhi(xv.x), w[k][1], o[1]); o[2] = fmaf(bflo(xv.y), w[k][2], o[2]); o[3] = fmaf(bfhi(xv.y), w[k][3], o[3]);
                o[4] = fmaf(bflo(xv.z), w[k][4], o[4]); o[5] = fmaf(bfhi(xv.z), w[k][5], o[5]); o[6] = fmaf(bflo(xv.w), w[k][6], o[6]); o[7] = fmaf(bfhi(xv.w), w[k][7], o[7]); }
            u32x4 wv; wv.x = pk2(o[0], o[1]); wv.y = pk2(o[2], o[3]); wv.z = pk2(o[4], o[5]); wv.w = pk2(o[6], o[7]);
            *(u32x4*)(U + (size_t)(seg0 + t0 + r) * RW + ch) = wv; }
    }
}

__device__ __forceinline__ void phase_prep2(const Args& a, const Ctx& c0, int l, bool last) {
    PHASE_BEGIN();
    const int gw = c.bid * 8 + c.wave, NGW = c.G * 8, lane = c.lane, hh = lane >> 3, s = lane & 7;
    const float* KR = WSP(const float, WS_KR); const float* RSTDK = WSP(const float, WS_RSTDK);
    const float* kn = INP(20) + (size_t)l * DQK; bf16* Ko = WSP(bf16, WS_K);
    const float inv0 = exp2f(-(float)(2 * s) * (13.287712379549449f / 16.f)), inv1 = exp2f(-(float)(2 * s + 1) * (13.287712379549449f / 16.f));
    const f32x2 g1 = *(const f32x2*)(kn + 128 + 2 * s), g2 = *(const f32x2*)(kn + 144 + 2 * s), g3 = *(const f32x2*)(kn + 160 + 2 * s), g4 = *(const f32x2*)(kn + 176 + 2 * s);
    for (int row0 = gw * 2; row0 < NR; row0 += NGW * 2) {
        f32x2 r1[2], r2[2], c1[2], c2[2]; float rk[2];
#pragma unroll
        for (int q = 0; q < 2; ++q) { const float* kr = KR + (size_t)(row0 + q) * 64;
            r1[q] = *(const f32x2*)(kr + 2 * s); r2[q] = *(const f32x2*)(kr + 16 + 2 * s); c1[q] = *(const f32x2*)(kr + 32 + 2 * s); c2[q] = *(const f32x2*)(kr + 48 + 2 * s);
            rk[q] = RSTDK[(size_t)(row0 + q) * 8 + hh]; }
#pragma unroll
        for (int q = 0; q < 2; ++q) { const int row = row0 + q;
            const bool lat = row < NL; const int b = lat ? (row >> 12) : ((row - NL) >> 8); const int t = lat ? (row & (SEQ - 1)) : ((row - NL) & (CTXL - 1));
            const int pos = lat ? CTXL + t : t; const size_t hrow = (size_t)(b * NH + hh) * KVLEN + pos;
            float cr0 = 1.f, sr0 = 0.f, cr1 = 1.f, sr1 = 0.f, cc0 = 1.f, sc0 = 0.f, cc1 = 1.f, sc1 = 0.f;
            if (lat) { const float pr = (float)(t >> 6), pc = (float)(t & 63);
                __sincosf(pr * inv0, &sr0, &cr0); __sincosf(pr * inv1, &sr1, &cr1); __sincosf(pc * inv0, &sc0, &cc0); __sincosf(pc * inv1, &sc1, &cc1); }
            const f32x2 a1 = r1[q] * rk[q] * g1, a2 = r2[q] * rk[q] * g2, b1 = c1[q] * rk[q] * g3, b2 = c2[q] * rk[q] * g4;
            bf16* ko = Ko + hrow * DQK;
            *(unsigned*)(ko + 128 + 2 * s) = pk2(a1.x * cr0 - a2.x * sr0, a1.y * cr1 - a2.y * sr1);
            *(unsigned*)(ko + 144 + 2 * s) = pk2(a2.x * cr0 + a1.x * sr0, a2.y * cr1 + a1.y * sr1);
            *(unsigned*)(ko + 160 + 2 * s) = pk2(b1.x * cc0 - b2.x * sc0, b1.y * cc1 - b2.y * sc1);
            *(unsigned*)(ko + 176 + 2 * s) = pk2(b2.x * cc0 + b1.x * sc0, b2.y * cc1 + b1.y * sc1); }
    }
    const float* AGG = WSP(const float, WS_AGG); float* CAR = WSP(float, WS_CARRY);
    for (int rep = 0; rep < NREP(15); ++rep)
    for (int it = c.bid; it < 16; it += c.G) {
        const int b = it >> 2, dir = (it >> 1) & 1, ch = (it & 1) * 512 + c.tid;
        const float* P = AGG + ((size_t)(dir * 2 + 0) * NB * NCHUNK + b * NCHUNK) * RW + ch; const float* S = AGG + ((size_t)(dir * 2 + 1) * NB * NCHUNK + b * NCHUNK) * RW + ch;
        float* Co = CAR + ((size_t)dir * NB * NCHUNK + b * NCHUNK) * RW + ch;
        float run = 0.f;
        if (dir == 0) {
#pragma unroll 17
            for (int q = 0; q < NCHUNK; ++q) { Co[(size_t)q * RW] = run; run = fmaf(P[(size_t)q * RW], run, S[(size_t)q * RW]); }
        } else {
#pragma unroll
            for (int q = 3; q >= 0; --q) { Co[(size_t)q * RW] = run; run = fmaf(P[(size_t)q * RW], run, S[(size_t)q * RW]); }
#pragma unroll 16
            for (int q = NCHUNK - 1; q >= 4; --q) { Co[(size_t)q * RW] = run; run = fmaf(P[(size_t)q * RW], run, S[(size_t)q * RW]); }
        }
    }
}

__device__ __forceinline__ void phase_attn(const Args& a, const Ctx& c0, int l, bool last) {
    PHASE_BEGIN();
    const bf16* QRAW = WSP(const bf16, WS_QRAW); const float* SSQ = WSP(const float, WS_SSQ); const bf16* K = WSP(const bf16, WS_K); const bf16* V = WSP(const bf16, WS_V); bf16* Y = WSP(bf16, WS_Y);
    const float* qn = INP(19) + (size_t)l * DQK;
    const int nun = last ? 512 : 544;
    for (int rep = 0; rep < NREP(13); ++rep)
    for (int u = c.bid; u < nun; u += c.G) {
        const bool isl = u < 512; const int bh = isl ? (u >> 4) : (u - 512), qb = u & 15, b = bh >> 3, h = bh & 7;
        const int grow0 = isl ? b * SEQ + qb * 256 : NL + b * CTXL;
        int tu = c0.tid; asm volatile("" : "+v"(tu));
        att::attn_unit(QRAW + (size_t)grow0 * 1536 + h * DQK, SSQ + (size_t)grow0 * 16, qn, isl ? qb * 256 : -1, K + (size_t)bh * KVLEN * DQK, V + (size_t)bh * KVLEN * DVH,
                       Y + (size_t)grow0 * DM + RW + h * DVH, isl ? KVLEN : CTXL, (LAS char*)c.lds, tu);
    }
    const char* HP = (const char*)WSP(const char, WS_AB); const float* CAR = WSP(const float, WS_CARRY); const bf16* GR = WSP(const bf16, WS_GR);
    int tid2 = c0.tid; asm volatile("" : "+v"(tid2));
    const int g4 = (tid2 & 255) * 4, rh = tid2 >> 8;
    for (int rep = 0; rep < NREP(14); ++rep)
    for (int it = c.G - 1 - c.bid; it < NB * NCHUNK; it += c.G) {
        const int b = it / NCHUNK, cc = it - b * NCHUNK; if (last && cc < 4) continue;
        const int r0 = (cc < 4 ? NL + b * CTXL + cc * 64 : b * SEQ + (cc - 4) * 64) + rh * 32;
        const f32x4 cf = *(const f32x4*)(CAR + ((size_t)0 * NB * NCHUNK + it) * RW + g4), cb = *(const f32x4*)(CAR + ((size_t)1 * NB * NCHUNK + it) * RW + g4);
        const char* hf = HP + ((size_t)r0 * 1024 + g4) * 4; const char* hb = hf + (size_t)NR * 1024 * 4;
        const bf16* zg = GR + (size_t)r0 * RW + g4; bf16* yo = Y + (size_t)r0 * DM + g4;
#pragma unroll 8
        for (int r = 0; r < 32; ++r) {
            const u32x4 wf = *(const u32x4*)(hf + (size_t)r * 4096), wb = *(const u32x4*)(hb + (size_t)r * 4096); const u32x2 gw2 = *(const u32x2*)(zg + (size_t)r * RW); const f32x4 gr = {bflo(gw2.x), bfhi(gw2.x), bflo(gw2.y), bfhi(gw2.y)};
            const float h0 = fmaf(bflo(wf.z), cf.x, bflo(wf.x)) + fmaf(bflo(wb.z), cb.x, bflo(wb.x)), h1 = fmaf(bfhi(wf.z), cf.y, bfhi(wf.x)) + fmaf(bfhi(wb.z), cb.y, bfhi(wb.x));
            const float h2 = fmaf(bflo(wf.w), cf.z, bflo(wf.y)) + fmaf(bflo(wb.w), cb.z, bflo(wb.y)), h3 = fmaf(bfhi(wf.w), cf.w, bfhi(wf.y)) + fmaf(bfhi(wb.w), cb.w, bfhi(wb.y));
            u32x2 w; w.x = pk2(h0 * gelu_tanh_(gr.x), h1 * gelu_tanh_(gr.y)); w.y = pk2(h2 * gelu_tanh_(gr.z), h3 * gelu_tanh_(gr.w));
            *(u32x2*)(yo + (size_t)r * DM) = w; }
    }
}

__device__ __forceinline__ void phase_router(const Args& a, const Ctx& c0, int l, bool last, int skip) {
    PHASE_BEGIN();
    LAS float* rl = (LAS float*)c.lds;
    const float* rt = INP(23) + (size_t)l * DM * NE;
    for (int i = c.tid; i < DM * NE; i += 512) { const int k = i >> 4, e = i & 15; rl[e * DM + k] = rt[i]; }
    __syncthreads();
    const int gw = (c.bid - skip) * 8 + c.wave, NGW = (c.G - skip) * 8, lane = c.lane, nrows = last ? NL : NR;
    const float* modv = WSP(const float, WS_MODV) + (size_t)l * 5 * NMODW; const float* g = INP(22) + (size_t)l * DM;
    const bf16* XM = WSP(const bf16, WS_XM); float* AFF = WSP(float, WS_AFF);
    const int n1 = skip ? NL / 2 : nrows / 2; int j0 = gw - n1 % NGW; if (j0 < 0) j0 += NGW;
    for (int ph = 0; ph < (skip ? 2 : 1); ++ph) {
    if (ph == 1 && NL / 2 + j0 < NR / 2) {
        unsigned* flag = WSP(unsigned, WS_CTL) + CW_CTXMIX; unsigned sp = 0;
        while (__hip_atomic_load(flag, __ATOMIC_RELAXED, __HIP_MEMORY_SCOPE_AGENT) < (unsigned)skip) { __builtin_amdgcn_s_sleep(2); if (++sp > (1u << 22)) break; }
        __builtin_amdgcn_fence(__ATOMIC_ACQUIRE, "agent"); }
    const int pr0 = ph == 0 ? gw : NL / 2 + j0, prend = ph == 0 ? n1 : NR / 2;
    u32x2 wa[8], wb[8];
    if (pr0 < prend) {
#pragma unroll
        for (int j = 0; j < 8; ++j) { wa[j] = ((const u32x2*)(XM + (size_t)(pr0 * 2) * DM))[lane + 64 * j]; wb[j] = ((const u32x2*)(XM + (size_t)(pr0 * 2 + 1) * DM))[lane + 64 * j]; } }
    for (int pr = pr0; pr < prend; pr += NGW) {
        const int row = pr * 2; const int mb = row < NL ? (row >> 12) : 4; const float* sh = modv + (size_t)mb * NMODW + 3 * DM; const float* scl = sh + DM;
        f32x4 va[8], vb[8]; float sa = 0.f, sb = 0.f;
#pragma unroll
        for (int j = 0; j < 8; ++j) { va[j] = (f32x4){bflo(wa[j].x), bfhi(wa[j].x), bflo(wa[j].y), bfhi(wa[j].y)}; vb[j] = (f32x4){bflo(wb[j].x), bfhi(wb[j].x), bflo(wb[j].y), bfhi(wb[j].y)}; }
        if (pr + NGW < prend) { const int nrow = (pr + NGW) * 2;
#pragma unroll
            for (int j = 0; j < 8; ++j) { wa[j] = ((const u32x2*)(XM + (size_t)nrow * DM))[lane + 64 * j]; wb[j] = ((const u32x2*)(XM + (size_t)(nrow + 1) * DM))[lane + 64 * j]; } }
#pragma unroll
        for (int j = 0; j < 8; ++j) { sa += dot4(va[j], va[j]); sb += dot4(vb[j], vb[j]); }
        const float ra = rsqrtf(wave_sum(sa) * (1.f / DM) + EPS), rb = rsqrtf(wave_sum(sb) * (1.f / DM) + EPS);
        unsigned char* orow = WSP(unsigned char, WS_H) + (size_t)row * DM;
#pragma unroll
        for (int j = 0; j < 8; ++j) { const int idx = (lane + 64 * j) * 4;
            const f32x4 gsv = *(const f32x4*)(g + idx) * (1.f + *(const f32x4*)(scl + idx)), shv = *(const f32x4*)(sh + idx);
            va[j] = (va[j] * ra) * gsv + shv; vb[j] = (vb[j] * rb) * gsv + shv;
            *(unsigned*)(orow + idx) = pk4_fp8(va[j].x, va[j].y, va[j].z, va[j].w); *(unsigned*)(orow + DM + idx) = pk4_fp8(vb[j].x, vb[j].y, vb[j].z, vb[j].w); }
        __builtin_amdgcn_sched_barrier(0);
        float pa[16], pb[16];
        f32x2 ab[8][4];
#pragma unroll
        for (int j = 0; j < 8; ++j) { ab[j][0] = (f32x2){va[j].x, vb[j].x}; ab[j][1] = (f32x2){va[j].y, vb[j].y}; ab[j][2] = (f32x2){va[j].z, vb[j].z}; ab[j][3] = (f32x2){va[j].w, vb[j].w}; }
#pragma unroll
        for (int e = 0; e < 16; ++e) { f32x2 x2 = {0.f, 0.f};
#pragma unroll
            for (int j = 0; j < 8; ++j) { const f32x4 rv = *(const LAS f32x4*)(rl + e * DM + (lane + 64 * j) * 4);
                x2 = __builtin_elementwise_fma(ab[j][0], (f32x2){rv.x, rv.x}, x2); x2 = __builtin_elementwise_fma(ab[j][1], (f32x2){rv.y, rv.y}, x2);
                x2 = __builtin_elementwise_fma(ab[j][2], (f32x2){rv.z, rv.z}, x2); x2 = __builtin_elementwise_fma(ab[j][3], (f32x2){rv.w, rv.w}, x2); }
            pa[e] = x2.x; pb[e] = x2.y; if (e & 1) __builtin_amdgcn_sched_barrier(0); }
#define TR_STEP(N, BIT) _Pragma("unroll") for (int i = 0; i < N; ++i) { const bool up = (lane & BIT) != 0; \
            const float sA = up ? pa[i] : pa[i + N], kA = up ? pa[i + N] : pa[i], sB = up ? pb[i] : pb[i + N], kB = up ? pb[i + N] : pb[i]; \
            pa[i] = kA + __shfl_xor(sA, BIT); pb[i] = kB + __shfl_xor(sB, BIT); }
        TR_STEP(8, 32) TR_STEP(4, 16) TR_STEP(2, 8) TR_STEP(1, 4)
#undef TR_STEP
        float la = pa[0], lb = pb[0];
        la += __shfl_xor(la, 1); lb += __shfl_xor(lb, 1); la += __shfl_xor(la, 2); lb += __shfl_xor(lb, 2);
        float ma = la, mbx = lb;
#pragma unroll
        for (int o = 4; o < 64; o <<= 1) { ma = fmaxf(ma, __shfl_xor(ma, o)); mbx = fmaxf(mbx, __shfl_xor(mbx, o)); }
        const float ea = __expf(la - ma), eb = __expf(lb - mbx); float da = ea, db = eb;
#pragma unroll
        for (int o = 4; o < 64; o <<= 1) { da += __shfl_xor(da, o); db += __shfl_xor(db, o); }
        if ((lane & 3) == 0) { AFF[(size_t)row * NE + (lane >> 2)] = ea / da; AFF[(size_t)(row + 1) * NE + (lane >> 2)] = eb / db; }
    }
    }
}

__device__ __forceinline__ void phase_topk(const Args& a, const Ctx& c0, int l, bool last) {
    PHASE_BEGIN();
    LAS unsigned* hist = (LAS unsigned*)c.lds;
    LAS unsigned* misc = hist + 256;
    LAS unsigned* wtot = misc + 16;
    LAS int* selrow = (LAS int*)(wtot + 16);
    const float* AFF = WSP(const float, WS_AFF); int* SEL = WSP(int, WS_SEL); int* IDXR = WSP(int, WS_IDXR); float* GATEV = WSP(float, WS_GATEV);
    const unsigned char* H = WSP(const unsigned char, WS_H); unsigned char* XG = WSP(unsigned char, WS_XG);
    const int tid = c.tid, lane = c.lane, wave = c.wave;
    const int nit = last ? 256 : 320;
    for (int it = c.bid; it < nit; it += c.G) {
        const int seg = it >= 256 ? 1 : 0, bi = seg ? it - 256 : (it >> 2), qd = seg ? 0 : (it & 3), b = bi >> 4, e = bi & 15;
        const int T = seg ? CTXL : SEQ, cap = seg ? CAP_C : CAP_L, row0 = seg ? NL + b * CTXL : b * SEQ, slot0 = seg ? NB * CAP_L + b * CAP_C : b * CAP_L;
        const int capq = seg ? CAP_C : CAP_L / 4; const unsigned slo = (unsigned)(qd * capq), shi = slo + (unsigned)capq; const int tq = T / (seg ? 1 : 4);
        unsigned k[8];
#pragma unroll
        for (int j = 0; j < 8; ++j) { const int t = tid * 8 + j; k[j] = t < T ? __float_as_uint(AFF[(size_t)(row0 + t) * NE + e]) : 0u; }
        unsigned prefix = 0u, mask = 0u, want = (unsigned)cap;
        for (int pass = 0; pass < 4; ++pass) { const int shift = 24 - 8 * pass;
            if (tid < 256) hist[tid] = 0u;
            __syncthreads();
#pragma unroll
            for (int j = 0; j < 8; ++j) if ((k[j] & mask) == prefix) atomicAdd((unsigned*)&hist[(k[j] >> shift) & 255u], 1u);
            __syncthreads();
            if (tid == 0) { unsigned cum = 0u; int d = 255; for (; d > 0; --d) { const unsigned hh = hist[d]; if (cum + hh >= want) break; cum += hh; } misc[0] = (unsigned)d; misc[1] = want - cum; }
            __syncthreads();
            prefix |= misc[0] << shift; mask |= 255u << shift; want = misc[1];
            __syncthreads();
        }
        const unsigned thr = prefix;
        unsigned cnt = 0u;
#pragma unroll
        for (int j = 0; j < 8; ++j) cnt += (k[j] > thr ? 1u : 0u) + (k[j] == thr ? 0x10000u : 0u);
        unsigned inc = cnt;
#pragma unroll
        for (int o = 1; o < 64; o <<= 1) { const unsigned v = __shfl_up(inc, o); if (lane >= o) inc += v; }
        if (lane == 63) wtot[wave] = inc;
        __syncthreads();
        unsigned base = 0u;
        for (int w = 0; w < wave; ++w) base += wtot[w];
        unsigned run = base + inc - cnt;
        unsigned gt_run = run & 0xffffu, eq_run = run >> 16;
#pragma unroll
        for (int j = 0; j < 8; ++j) { const int t = tid * 8 + j;
            if (t < T) { const bool g = k[j] > thr, q = k[j] == thr; const bool sel = g || (q && eq_run < want);
                const unsigned slot = gt_run + (eq_run < want ? eq_run : want);
                if (sel && slot >= slo && slot < shi) { IDXR[e * EROWS + slot0 + slot] = row0 + t; GATEV[e * EROWS + slot0 + slot] = __uint_as_float(k[j]); selrow[slot - slo] = row0 + t;
                    SEL[(size_t)(row0 + t) * NE + e] = (int)(slot0 + slot); }
                if (!sel && t / tq == qd) SEL[(size_t)(row0 + t) * NE + e] = -1;
                gt_run += g ? 1u : 0u; eq_run += q ? 1u : 0u; } }
        __syncthreads();
        for (int s0 = wave * 8; s0 < capq; s0 += 64) {
            u32x4 t[8][2];
#pragma unroll
            for (int q = 0; q < 8; ++q) { const u32x4* src = (const u32x4*)(H + (size_t)selrow[s0 + q] * DM);
#pragma unroll
                for (int j = 0; j < 2; ++j) t[q][j] = src[lane + 64 * j]; }
#pragma unroll
            for (int q = 0; q < 8; ++q) { u32x4* dst = (u32x4*)(XG + ((size_t)e * EROWS + slot0 + slo + s0 + q) * DM);
#pragma unroll
                for (int j = 0; j < 2; ++j) dst[lane + 64 * j] = t[q][j]; } }
        if (seg == 1 && b == 0) {
            u32x4* dst = (u32x4*)(XG + ((size_t)e * EROWS + 2176) * DM);
            for (int i = tid; i < 128 * DM / 16; i += 512) dst[i] = (u32x4){0u, 0u, 0u, 0u};
            if (tid < 128) GATEV[e * EROWS + 2176 + tid] = 0.f; }
        __syncthreads();
    }
}

__device__ __forceinline__ void phase_combine(const Args& a, const Ctx& c0, int l, bool last_in) {
    PHASE_BEGIN();
    const bool last = last_in;
    const int gw = c.bid * 8 + c.wave, NGW = c.G * 8, lane = c.lane, nrows = last ? NL : NR;
    const bf16* XM = WSP(const bf16, WS_XM); const int* SEL = WSP(const int, WS_SEL); const bf16* YE = WSP(const bf16, WS_YE);
    const float* modv = WSP(const float, WS_MODV) + (size_t)l * 5 * NMODW;
    float* out = a.out; bf16* x1o = WSP(bf16, WS_X1);
    for (int row = gw; row < nrows; row += NGW) {
        const int mb = row < NL ? (row >> 12) : 4; const float* g2 = modv + (size_t)mb * NMODW + 5 * DM;
        const int myslot = lane < 16 ? SEL[(size_t)row * NE + lane] : -1;
        f32x4 xv[4][2], gv[4][2];
#pragma unroll
        for (int j = 0; j < 4; ++j) { const int idx = (lane + 64 * j) * 8; const u32x4 xw = *(const u32x4*)(XM + (size_t)row * DM + idx);
            xv[j][0] = (f32x4){bflo(xw.x), bfhi(xw.x), bflo(xw.y), bfhi(xw.y)}; xv[j][1] = (f32x4){bflo(xw.z), bfhi(xw.z), bflo(xw.w), bfhi(xw.w)};
#pragma unroll
            for (int hlf = 0; hlf < 2; ++hlf) gv[j][hlf] = *(const f32x4*)(g2 + idx + hlf * 4); }
        f32x4 acc[4][2];
#pragma unroll
        for (int j = 0; j < 4; ++j) { acc[j][0] = (f32x4){0.f, 0.f, 0.f, 0.f}; acc[j][1] = (f32x4){0.f, 0.f, 0.f, 0.f}; }
        unsigned long long m = __ballot(myslot >= 0);
        while (m) { const int e = __builtin_ctzll(m); m &= m - 1; const int sl = __shfl(myslot, e);
            const u32x4* y = (const u32x4*)(YE + ((size_t)e * EROWS + sl) * DM);
#pragma unroll
            for (int j = 0; j < 4; ++j) { const u32x4 w = y[lane + 64 * j];
                acc[j][0] += (f32x4){bflo(w.x), bfhi(w.x), bflo(w.y), bfhi(w.y)}; acc[j][1] += (f32x4){bflo(w.z), bfhi(w.z), bflo(w.w), bfhi(w.w)}; } }
        float ssn = 0.f;
#pragma unroll
        for (int j = 0; j < 4; ++j) { const int idx = (lane + 64 * j) * 8;
#pragma unroll
            for (int hlf = 0; hlf < 2; ++hlf) { xv[j][hlf] = xv[j][hlf] + gv[j][hlf] * acc[j][hlf]; ssn += dot4(xv[j][hlf], xv[j][hlf]); }
            if (last) { *(f32x4*)(out + (size_t)row * DM + idx) = xv[j][0]; *(f32x4*)(out + (size_t)row * DM + idx + 4) = xv[j][1]; }
            else { u32x4 w; w.x = pk2(xv[j][0].x, xv[j][0].y); w.y = pk2(xv[j][0].z, xv[j][0].w); w.z = pk2(xv[j][1].x, xv[j][1].y); w.w = pk2(xv[j][1].z, xv[j][1].w); *(u32x4*)(x1o + (size_t)row * DM + idx) = w; } }
        if (!last) {
            const float* mv1 = modv + (size_t)5 * NMODW + (size_t)mb * NMODW; const float* g1n = INP(6) + (size_t)(l + 1) * DM;
            const float rstd = rsqrtf(wave_sum(ssn) * (1.f / DM) + EPS); bf16* hrow = WSP(bf16, WS_H) + (size_t)row * DM;
#pragma unroll
            for (int j = 0; j < 4; ++j) { const int idx = (lane + 64 * j) * 8; u32x4 w;
#pragma unroll
                for (int hlf = 0; hlf < 2; ++hlf) { const int ix = idx + hlf * 4; const f32x4 gsv = *(const f32x4*)(g1n + ix) * (1.f + *(const f32x4*)(mv1 + DM + ix)), shv = *(const f32x4*)(mv1 + ix);
                    const f32x4 o = (xv[j][hlf] * rstd) * gsv + shv;
                    if (hlf == 0) { w.x = pk2(o.x, o.y); w.y = pk2(o.z, o.w); } else { w.z = pk2(o.x, o.y); w.w = pk2(o.z, o.w); } }
                *(u32x4*)(hrow + idx) = w; } }
    }
}

constexpr int PH_PER_LAYER = 12, NPH = 1 + 2 * PH_PER_LAYER;
__global__ void __launch_bounds__(512, 2) mk_fwd(Args a) {
    extern __shared__ __attribute__((aligned(16))) unsigned char lds_raw[];
    Ctx c; c.lds = (LAS unsigned char*)lds_raw; c.tid = threadIdx.x; c.lane = c.tid & 63; c.wave = __builtin_amdgcn_readfirstlane(c.tid >> 6); c.bid = blockIdx.x; c.G = gridDim.x;
    volatile LAS unsigned* MISC = (volatile LAS unsigned*)(c.lds + LDS_MISC);
    if (c.tid < 32) MISC[c.tid] = 0u;
    __syncthreads();
    XcdBarrier bar; bar.bar = (unsigned*)(a.ws + WS_CTL) + 4096; bar.x = 0; bar.st = nullptr;
    const int lo = a.ph_lo, hi = a.ph_hi;
    if (hi - lo > 1) bar = xcd_barrier_post((unsigned*)(a.ws + WS_CTL) + 4096, MISC + 8);
#ifndef PH_MASK
#define PH_MASK 0x1fff
#endif
#define EN(j) ((PH_MASK >> (j)) & 1)

#define IN(k) (lo <= (k) && (k) < hi)
#define SEAM(k) do { if (IN(k) && IN((k) + 1)) { XcdBarrier b_ = bar; { GAS unsigned* t_ = (GAS unsigned*)b_.bar; asm volatile("" : "+s"(t_)); b_.bar = (unsigned*)t_; } xcd_barrier(b_); } } while (0)

    if (EN(12) && IN(0)) for (int rep = 0; rep < NREP(12); ++rep) { phase_mod(a, c); }
    SEAM(0);
    if (hi - lo > 1) {
        if (c.tid == 0) { unsigned* bw = (unsigned*)(a.ws + WS_CTL) + 4096; bool even = (c.G % 8) == 0;
            for (unsigned j = 0; j < 8; ++j) even = even && (xb_ld(&bw[XB_XCNT(j)]) == (unsigned)(c.G / 8));
            MISC[12] = even ? (MISC[10] * 8u + bar.x) : (unsigned)c.bid; }
        __syncthreads();
        c.bid = (int)MISC[12];
    }
    for (int l = 0; l < 2; ++l) {
        const int pb = 1 + l * PH_PER_LAYER; const bool last = (l == 1);
        if (l == 0) {
            if (EN(0) && IN(pb + 0)) for (int rep = 0; rep < NREP(0); ++rep) { phase_l0(a, c, l); }
            SEAM(pb + 0);
        }
        if (EN(1) && IN(pb + 1)) for (int rep = 0; rep < NREP(1); ++rep) {
            GAS unsigned char* wsb = (GAS unsigned char*)a.ws; asm volatile("" : "+s"(wsb));
            ProbIn p; p.K = DM; p.lda = DM; p.ldb = DM; p.ord.init(NR / 256, INWP / 256, c.G, c.bid); p.A = (const char*)WSP(bf16, WS_H); p.Bt = (const char*)WSW(bf16, W_IN, l);
            p.XR = WSP(bf16, WS_XR); p.GR = WSP(bf16, WS_GR); p.CQ = WSP(bf16, WS_CQ); p.CKV = WSP(bf16, WS_CKV); p.KR = WSP(float, WS_KR); p.SSQ = WSP(float, WS_SSQ);
            pg8::gemm_phase(c.lds, p); }
#if BG_FILL_GEMM_TAILS
        if (IN(pb + 1)) bg_fill(a, c, l * 8 + 1, 0);
#endif
        SEAM(pb + 1);
        if (EN(2) && IN(pb + 2)) for (int rep = 0; rep < NREP(2); ++rep) { phase_conv(a, c, l); }
        SEAM(pb + 2);
        if (EN(3) && IN(pb + 3)) for (int rep = 0; rep < NREP(3); ++rep) {
            GAS unsigned char* wsb = (GAS unsigned char*)a.ws; asm volatile("" : "+s"(wsb));
#ifndef NO_QKV
            { ProbQ p; p.K = QRANK; p.lda = QRANK; p.ldb = QRANK; p.ord.init((last ? NL : NR) / 256, 1536 / 256, c.G, c.bid); p.A = (const char*)WSP(bf16, WS_CQ); p.Bt = (const char*)WSW(bf16, W_UQ, l); p.O = WSP(bf16, WS_QRAW);
              pg8::gemm_phase(c.lds, p); }
            { ProbKV p; p.K = KVRANK; p.lda = KVRANK; p.ldb = KVRANK; p.ord.init(NR / 256, NH, c.G, (c.bid + c.G - 216) % c.G); p.A = (const char*)WSP(bf16, WS_CKV);   p.Bt = (const char*)WSW(bf16, W_UKV, l); p.Ko = WSP(bf16, WS_K); p.Vo = WSP(bf16, WS_V);
              p.SSQ = WSP(const float, WS_SSQ); p.RSTDK = WSP(float, WS_RSTDK); p.kn = INP(20) + (size_t)l * DQK; p.part = (LAS float*)(c.lds + 131072);
              pg8::gemm_phase(c.lds, p); }
#endif
#ifndef NO_GATES
            { ProbGates p; p.K = 128; p.lda = RW; p.ldb = 128; p.ord.init(NR / 256, 16, c.G, (c.bid + c.G - 152) % c.G); p.U = (const char*)WSP(bf16, WS_U);   p.Bt = (const char*)WSW(bf16, W_GT, l); p.HP = (char*)WSP(char, WS_AB); p.AGG = WSP(float, WS_AGG);
              p.ba = INP(11) + (size_t)l * 2 * RW; p.bx = INP(13) + (size_t)l * 2 * RW; p.lam = WSP(const float, WS_LSL) + (size_t)l * 2 * RW;
              pg8::gemm_phase(c.lds, p); }
#endif
        }
#if BG_FILL_GEMM_TAILS
        if (IN(pb + 3)) bg_fill(a, c, l * 8 + 2, 0);
#endif
        SEAM(pb + 3);
        if (EN(4) && IN(pb + 4)) for (int rep = 0; rep < NREP(4); ++rep) { phase_prep2(a, c, l, last); }
        SEAM(pb + 4);
        if (IN(pb + 5) && (c.bid & 1) == 0) { if (l == 0) mod_items(a, c, 1); bg_take(a, c, l == 0 ? (c.bid < 32 ? 22 : c.bid < 192 ? 26 : c.bid < 240 ? 29 : 27) : 24); }
        if (EN(5) && IN(pb + 5)) for (int rep = 0; rep < NREP(5); ++rep) { phase_attn(a, c, l, last); }
        if (IN(pb + 5) && (c.bid & 1) == 1) { bg_take(a, c, l == 0 ? (c.bid < 32 ? 22 : c.bid < 192 ? 26 : c.bid < 240 ? 29 : 27) : 24); if (l == 0) mod_items(a, c, 1); }
#if BG_FILL_GEMM_TAILS
        if (IN(pb + 5) && l == 0) bg_fill(a, c, 3, 0);
#endif
        SEAM(pb + 5);
        if (EN(6) && IN(pb + 6)) for (int rep = 0; rep < NREP(6); ++rep) {
            GAS unsigned char* wsb = (GAS unsigned char*)a.ws; asm volatile("" : "+s"(wsb));
            const bool split = !last && c.G >= 64;
            ProbMixer p; p.K = DM; p.lda = DM; p.ldb = DM; p.ord.init((last || split ? NL : NR) / 256, DM / 256, c.G, c.bid); p.pm0 = 0; p.A = (const char*)WSP(bf16, WS_Y); p.Bt = (const char*)WSW(bf16, W_OUT, l);
            p.xl = l == 0 ? INP(0) : nullptr; p.xc = l == 0 ? INP(2) : nullptr; p.x1 = WSP(const bf16, WS_X1); p.XM = WSP(bf16, WS_XM); p.modv = WSP(const float, WS_MODV) + (size_t)l * 5 * NMODW;
            pg8::gemm_phase(c.lds, p); }
#if BG_FILL_GEMM_TAILS
        if (IN(pb + 6) && l == 0) bg_fill(a, c, 4, 0);
#endif
        SEAM(pb + 6);
        if (EN(7) && IN(pb + 7)) for (int rep = 0; rep < NREP(7); ++rep) {
            const bool split = !last && c.G >= 64;
            if (split && c.bid < 32) {
                GAS unsigned char* wsb = (GAS unsigned char*)a.ws; asm volatile("" : "+s"(wsb));
                ProbMixer p; p.K = DM; p.lda = DM; p.ldb = DM; p.ord.init(NC / 256, DM / 256, 32, c.bid); p.pm0 = NL / 256; p.A = (const char*)WSP(bf16, WS_Y); p.Bt = (const char*)WSW(bf16, W_OUT, l);
                p.xl = l == 0 ? INP(0) : nullptr; p.xc = l == 0 ? INP(2) : nullptr; p.x1 = WSP(const bf16, WS_X1); p.XM = WSP(bf16, WS_XM); p.modv = WSP(const float, WS_MODV) + (size_t)l * 5 * NMODW;
                pg8::gemm_phase(c.lds, p);
                asm volatile("s_waitcnt vmcnt(0)" ::: "memory"); __syncthreads();
                if (threadIdx.x == 0) { __builtin_amdgcn_fence(__ATOMIC_RELEASE, "agent"); __hip_atomic_fetch_add(WSP(unsigned, WS_CTL) + CW_CTXMIX, 1u, __ATOMIC_RELAXED, __HIP_MEMORY_SCOPE_AGENT); }
            } else phase_router(a, c, l, last, split ? 32 : 0); }
        SEAM(pb + 7);
        if (EN(8) && IN(pb + 8)) for (int rep = 0; rep < NREP(8); ++rep) { phase_topk(a, c, l, last); }
        if (IN(pb + 8)) bg_fill(a, c, l * 8 + 5, l == 0 ? BG_E0 : BG_E1);
        SEAM(pb + 8);
        if (EN(9) && IN(pb + 9)) for (int rep = 0; rep < NREP(9); ++rep) {
            GAS unsigned char* wsb = (GAS unsigned char*)a.ws; asm volatile("" : "+s"(wsb));
            ProbGateUp p; p.K = DM; p.lda = DM; p.ldb = DM; p.tpe = last ? 8 : 9; p.ord.init(NE * p.tpe, 16, c.G, c.bid, p.tpe); p.XG = (const char*)WSP(unsigned char, WS_XG); p.Bt = (const char*)WSW(unsigned char, W_GU, l); p.ACT = WSP(unsigned char, WS_ACT);
            pg8::gemm_phase(c.lds, p); }
        SEAM(pb + 9);
        if (EN(10) && IN(pb + 10)) for (int rep = 0; rep < NREP(10); ++rep) {
            GAS unsigned char* wsb = (GAS unsigned char*)a.ws; asm volatile("" : "+s"(wsb));
            ProbDown p; p.K = DM; p.lda = DM; p.ldb = DM; p.tpe = last ? 8 : 9; p.ord.init(NE * p.tpe, 8, c.G, c.bid, p.tpe); p.ACT = (const char*)WSP(unsigned char, WS_ACT); p.Bt = (const char*)WSW(unsigned char, W_DN, l); p.YE = WSP(bf16, WS_YE); p.gatev = WSP(const float, WS_GATEV);
            pg8::gemm_phase(c.lds, p); }
#if BG_FILL_GEMM_TAILS
        if (IN(pb + 10) && l == 0) bg_fill(a, c, 6, 0);
#endif
        SEAM(pb + 10);
        if (EN(11) && IN(pb + 11)) for (int rep = 0; rep < NREP(11); ++rep) { phase_combine(a, c, l, last); }
        if (IN(pb + 11) && l == 0) bg_fill(a, c, 8, BG_E1S);
        SEAM(pb + 11);
    }
#undef IN
#undef SEAM
}

extern "C" void kernel_launch(void* const* d_in, const int* in_sizes, int n_in, void* d_out, int out_size, void* d_ws, size_t ws_size, hipStream_t stream) {
    static int grid = 0;
    if (grid == 0) {
        if (n_in != 27 || out_size != NL * DM || ws_size < WS_END) { fprintf(stderr, "kernel_launch: unexpected shapes (n_in %d out %d ws %zu)\n", n_in, out_size, ws_size); grid = -1; return; }
        int dev = 0, cus = 0, per_cu = 0;
        if (hipGetDevice(&dev) != hipSuccess || hipDeviceGetAttribute(&cus, hipDeviceAttributeMultiprocessorCount, dev) != hipSuccess) { grid = -1; return; }
        if (hipFuncSetAttribute((const void*)mk_fwd, hipFuncAttributeMaxDynamicSharedMemorySize, LDS_BYTES) != hipSuccess) { fprintf(stderr, "kernel_launch: hipFuncSetAttribute failed\n"); grid = -1; return; }
        if (hipOccupancyMaxActiveBlocksPerMultiprocessor(&per_cu, (const void*)mk_fwd, 512, LDS_BYTES) != hipSuccess || per_cu < 1) { fprintf(stderr, "kernel_launch: occupancy query says %d\n", per_cu); }
        (void)hipGetLastError();
        grid = cus;
    }
    if (grid < 0) return;
    (void)hipMemsetAsync((char*)d_ws + WS_CTL, 0, CTL_BYTES, stream);
    Args a{};
    for (int i = 0; i < 27; ++i) a.in[i] = (const float*)d_in[i];
    a.out = (float*)d_out; a.ws = (unsigned char*)d_ws;
#if MK_ONE_LAUNCH
    a.ph_lo = 0; a.ph_hi = NPH;
    hipLaunchKernelGGL(mk_fwd, dim3(grid), dim3(512), LDS_BYTES, stream, a);
#else
    for (int k = 0; k < NPH; ++k) { a.ph_lo = k; a.ph_hi = k + 1; hipLaunchKernelGGL(mk_fwd, dim3(grid), dim3(512), LDS_BYTES, stream, a); }
#endif
    const hipError_t le = hipPeekAtLastError();
    if (le != hipSuccess) fprintf(stderr, "kernel_launch: launch failed: %s\n", hipGetErrorName(le));
}
```

```cpp
#include <hip/hip_runtime.h>
#include <cstdio>
#include <cstdint>

#define LAS __attribute__((address_space(3)))
#define GAS __attribute__((address_space(1)))
typedef unsigned short bf16;
typedef short bf16x8 __attribute__((ext_vector_type(8)));
typedef short s16x4 __attribute__((ext_vector_type(4)));
typedef float f32x4 __attribute__((ext_vector_type(4)));
typedef float f32x2 __attribute__((ext_vector_type(2)));
typedef float f32x16 __attribute__((ext_vector_type(16)));
typedef unsigned u32x4 __attribute__((ext_vector_type(4)));
typedef unsigned u32x2 __attribute__((ext_vector_type(2)));
typedef int v4i __attribute__((ext_vector_type(4)));
typedef int v8i __attribute__((ext_vector_type(8)));

#ifndef BG_FILL_GEMM_TAILS
#define BG_FILL_GEMM_TAILS 0
#endif
#ifndef MK_ONE_LAUNCH
#define MK_ONE_LAUNCH 1
#endif

constexpr int DM = 2048, NB = 4, SEQ = 4096, CTXL = 256;
constexpr int NL = NB * SEQ, NC = NB * CTXL, NR = NL + NC;
constexpr int RW = 1024, NH = 8, DQK = 192, DVH = 128;
constexpr int QRANK = 512, KVRANK = 256, INW = 2880, INWP = 3072;
constexpr int NE = 16, NMODW = 6 * DM;
constexpr int CAP_L = 512, CAP_C = 32, EROWS = 2304;
constexpr int KVLEN = CTXL + SEQ;
constexpr int NCHUNK = 68;
constexpr float EPS = 1e-6f;

constexpr size_t MiB = 1u << 20;
constexpr size_t WS_CTL = 0, CTL_BYTES = 1 * MiB;
constexpr size_t WS_MODV = 1 * MiB, WS_AFF = 2 * MiB, WS_SEL = 4 * MiB, WS_IDXR = 6 * MiB, WS_GATEV = 6 * MiB + 512 * 1024, WS_AGG = 8 * MiB, WS_CARRY = 13 * MiB, WS_LSL = 15 * MiB + 512 * 1024;
constexpr size_t WS_WSET = 16 * MiB, WSET_STRIDE = 410 * MiB;
constexpr size_t W_IN = 0, W_UQ = 12 * MiB, W_UKV = 14 * MiB, W_GT = 15 * MiB, W_OUT = 18 * MiB, W_GU = 26 * MiB, W_DN = 282 * MiB;
constexpr size_t WS_H = 836 * MiB, WS_U = 904 * MiB, WS_AB = 938 * MiB;
constexpr size_t WS_K = 1074 * MiB, WS_V = 1125 * MiB, WS_Y = 1159 * MiB, WS_XM = 1227 * MiB, WS_X1 = 1363 * MiB;
constexpr size_t WS_OV = 1499 * MiB;
constexpr size_t WS_XR = WS_OV, WS_GR = WS_OV + 34 * MiB, WS_CQ = WS_OV + 68 * MiB, WS_CKV = WS_OV + 85 * MiB, WS_KR = WS_OV + 94 * MiB, WS_QRAW = WS_OV + 99 * MiB, WS_SSQ = WS_OV + 150 * MiB, WS_RSTDK = WS_OV + 152 * MiB;
constexpr size_t WS_XG = WS_OV, WS_ACT = WS_OV + 144 * MiB, WS_YE = WS_OV + 288 * MiB, WS_END = WS_OV + 432 * MiB;
static_assert(WS_YE + (size_t)NE * EROWS * DM * 2 <= WS_END && WS_END <= 2048 * MiB, "workspace map");
constexpr int CW_QHEAD = 8192, CW_QDONE = 8256;
constexpr int T_SMALL = 32 * 45 + 8 * 24 + 4 * 32 + 32 * 32, T_MOE = 3 * NE * 32 * 32, T_LAYER = T_SMALL + T_MOE;
constexpr int BG_TILES = T_MOE + T_LAYER, BG_STEPS = BG_TILES / 8;
constexpr int BG_E0 = T_MOE / 8, BG_E1S = (T_MOE + T_SMALL) / 8, BG_E1 = BG_STEPS;
static_assert(T_MOE % 8 == 0 && T_SMALL % 8 == 0, "step granularity");

constexpr int CW_CTXMIX = 12000;
constexpr int LDS_BYTES = 163840;
constexpr int LDS_MISC = LDS_BYTES - 4096;

struct Args { const float* in[27]; float* out; unsigned char* ws; int ph_lo, ph_hi; };

__device__ __forceinline__ unsigned f2bf(float f) { unsigned u = __builtin_bit_cast(unsigned, f); return (u + 0x7fffu + ((u >> 16) & 1u)) >> 16; }
__device__ __forceinline__ unsigned pk2(float lo, float hi) { return f2bf(lo) | (f2bf(hi) << 16); }
__device__ __forceinline__ float bf2f(unsigned short b) { return __builtin_bit_cast(float, (unsigned)b << 16); }
__device__ __forceinline__ float bflo(unsigned w) { return __builtin_bit_cast(float, w << 16); }
__device__ __forceinline__ float bfhi(unsigned w) { return __builtin_bit_cast(float, w & 0xffff0000u); }
__device__ __forceinline__ float wave_sum(float v) {
#pragma unroll
    for (int o = 1; o < 64; o <<= 1) v += __shfl_xor(v, o);
    return v;
}
__device__ __forceinline__ float sigmoid_(float x) { return 1.f / (1.f + __expf(-x)); }
__device__ __forceinline__ float silu_(float x) { return x * sigmoid_(x); }
__device__ __forceinline__ float sigmoid_fast(float x) { return __builtin_amdgcn_rcpf(1.f + __expf(-x)); }
__device__ __forceinline__ float silu_fast(float x) { return x * sigmoid_fast(x); }
__device__ __forceinline__ float one_minus_exp(float x) { const float p = -x * (1.f + x * (0.5f + x * (0.16666667f + x * (0.041666668f + x * 0.0083333338f)))); return x > -0.1f ? p : 1.f - __expf(x); }
__device__ __forceinline__ float gelu_tanh_(float x) { const float u = 0.7978845608028654f * (x + 0.044715f * x * x * x); const float t = 1.f - 2.f / (1.f + __expf(2.f * u)); return 0.5f * x * (1.f + t); }
__device__ __forceinline__ float sat8(float x) { return __builtin_amdgcn_fmed3f(x, -448.f, 448.f); }
__device__ __forceinline__ unsigned pk4_fp8(float a, float b, float c, float d) { int w = __builtin_amdgcn_cvt_pk_fp8_f32(sat8(a), sat8(b), 0, false); w = __builtin_amdgcn_cvt_pk_fp8_f32(sat8(c), sat8(d), w, true); return (unsigned)w; }
constexpr float W8_SCALE = 64.f;
__device__ __forceinline__ float dot4(f32x4 a, f32x4 b) { return (a.x * b.x + a.y * b.y) + (a.z * b.z + a.w * b.w); }

#define XB_TMO      128
#define XB_XCNT(j)  (256  + 64 * (j))
#define XB_XSUB(j)  (1280 + 64 * (j))
#define XB_XGEN(j)  (2304 + 64 * (j))
#define XB_TOP      3328
#define XB_TOPGEN   3392
#define XCD_BAR_WORDS 3456
#define XB_SPIN_CAP (1u << 18)
__device__ __forceinline__ unsigned xb_ld(unsigned* p)              { return __hip_atomic_load(p, __ATOMIC_RELAXED, __HIP_MEMORY_SCOPE_AGENT); }
__device__ __forceinline__ unsigned xb_add(unsigned* p, unsigned v) { return __hip_atomic_fetch_add(p, v, __ATOMIC_RELAXED, __HIP_MEMORY_SCOPE_AGENT); }
__device__ __forceinline__ unsigned xb_xcc_id() { return (unsigned)__builtin_amdgcn_s_getreg((3 << 11) | 20) & 0xFu; }
#define XB_SPIN(cond, bar) do { unsigned _sp = 0; while (cond) { __builtin_amdgcn_s_sleep(1); \
    if ((++_sp & 255u) == 0u) { if (xb_ld(&(bar)[XB_TMO])) break; if (_sp > XB_SPIN_CAP) { atomicAdd(&(bar)[XB_TMO], 1u); break; } } } } while (0)
struct XcdBarrier { unsigned* bar; unsigned x; volatile LAS unsigned* st; };
__device__ __forceinline__ XcdBarrier xcd_barrier_post(unsigned* bar, volatile LAS unsigned* st) {
    XcdBarrier b; b.bar = bar; b.x = xb_xcc_id(); b.st = st;
    if (threadIdx.x == 0) st[2] = xb_add(&bar[XB_XCNT(b.x)], 1u);
    return b;
}
__device__ __forceinline__ void xcd_barrier_complete(unsigned* bar, unsigned x, unsigned& nloc, unsigned& nx) {
    const unsigned G = gridDim.x * gridDim.y * gridDim.z;
    unsigned sum, cnt, mine, sp = 0u;
    for (;;) {
        sum = 0u; cnt = 0u; mine = 0u;
#pragma unroll
        for (unsigned j = 0; j < 16; ++j) { const unsigned c = xb_ld(&bar[XB_XCNT(j)]); sum += c; cnt += (c > 0u) ? 1u : 0u; mine = (j == x) ? c : mine; }
        if (sum == G) break;
        __builtin_amdgcn_s_sleep(1);
        if ((++sp & 255u) == 0u) { if (xb_ld(&bar[XB_TMO])) break; if (sp > XB_SPIN_CAP) { atomicAdd(&bar[XB_TMO], 1u); break; } }
    }
    nloc = mine > 0u ? mine : 1u; nx = cnt > 0u ? cnt : 1u;
}
__device__ __forceinline__ void xcd_barrier(const XcdBarrier& b) {
    asm volatile("s_waitcnt vmcnt(0)" ::: "memory");
    __syncthreads();
    if (threadIdx.x == 0) {
        unsigned* bar = b.bar;
        __builtin_amdgcn_s_waitcnt(0);
        unsigned nloc = b.st[0], nx = b.st[1];
        if (nloc == 0u) { xcd_barrier_complete(bar, b.x, nloc, nx); b.st[0] = nloc; b.st[1] = nx; }
        const unsigned old = xb_add(&bar[XB_XSUB(b.x)], 1u);
        const unsigned gen = old / nloc;
        if (old + 1u == (gen + 1u) * nloc) {
            __builtin_amdgcn_fence(__ATOMIC_RELEASE, "agent");
            asm volatile("s_waitcnt vmcnt(0)" ::: "memory");
            const unsigned og = xb_add(&bar[XB_TOP], 1u);
            const unsigned tg = og / nx;
            if (og + 1u == (tg + 1u) * nx) xb_add(&bar[XB_TOPGEN], 1u);
            else XB_SPIN(xb_ld(&bar[XB_TOPGEN]) == tg, bar);
            __builtin_amdgcn_fence(__ATOMIC_ACQUIRE, "agent");
            xb_add(&bar[XB_XGEN(b.x)], 1u);
            asm volatile("s_waitcnt vmcnt(0)" ::: "memory");
        } else {
            XB_SPIN(xb_ld(&bar[XB_XGEN(b.x)]) == gen, bar);
            __builtin_amdgcn_fence(__ATOMIC_ACQUIRE, "agent");
            asm volatile("s_waitcnt vmcnt(0)" ::: "memory");
        }
    }
    __syncthreads();
}

namespace pg8 {
constexpr int BM = 256, BK = 64, HALF = 128, HTB = HALF * BK * 2, STAGE_BYTES = 8 * HTB, NXCD = 8, WGM = 8;
__device__ __forceinline__ int lds_byte(int r, int c) { const int st = (r >> 4) * 2 + (c >> 5), rr = r & 15, cc = c & 31, ob = rr * 64 + cc * 2; return st * 1024 + (ob ^ (((ob >> 9) & 1) << 5)); }
__device__ __forceinline__ void stage_rc(int b, int& R, int& C) { const int st = b / 1024, sb = b % 1024, swz = sb ^ (((sb >> 9) & 1) << 5); R = (st >> 1) * 16 + swz / 64; C = (st & 1) * 32 + (swz % 64) / 2; }
__device__ __forceinline__ int perm32(int rho) { const int n = rho >> 4, i = rho & 15; return 8 * (i >> 2) + 4 * n + (i & 3); }
struct Unit { int pm, pn; };
struct TileOrder {
    int nM, nN, nwg, G, c, wgm;
    __device__ __forceinline__ void init(int nM_, int nN_, int G_, int c_, int wgm_ = WGM) { nM = nM_; nN = nN_; nwg = nM * nN; G = G_; c = c_; wgm = wgm_; }
    __device__ __forceinline__ bool next(int i, Unit& u) const {
        const long L = (long)i * G + c; if (L >= nwg) return false;
        int wgid = (int)L; { const int q = nwg / NXCD, r = nwg % NXCD, xcd = wgid % NXCD, off = wgid / NXCD; wgid = (xcd < r ? xcd * (q + 1) : r * (q + 1) + (xcd - r) * q) + off; }
        const int nig = wgm * nN, gid = wgid / nig, fm = gid * wgm, gsz = (nM - fm) < wgm ? (nM - fm) : wgm;
        u.pm = fm + ((wgid % nig) % gsz); u.pn = (wgid % nig) / gsz; return true;
    }
};
template <class P>
__device__ __forceinline__ void gemm_phase(LAS unsigned char* lds, const P& p) {
    int tid_ = threadIdx.x; asm volatile("" : "+v"(tid_));
    const int tid = tid_, wid = __builtin_amdgcn_readfirstlane(tid >> 6), lane = tid & 63, wr = wid >> 2, wc = wid & 3, fr = lane & 15, fq = lane >> 4;
    constexpr int EB = P::EB;
    int nt_ = p.K * EB / 128; asm volatile("" : "+s"(nt_)); const int nt = nt_;
    unsigned voffA[2], voffB[2];
#pragma unroll
    for (int i = 0; i < 2; ++i) { int R, C; stage_rc(tid * 16 + i * 8192, R, C); const int Rb = P::PERM ? ((R & ~31) + perm32(R & 31)) : R;
        voffA[i] = (unsigned)(R * p.lda * EB + C * 2); voffB[i] = (unsigned)(Rb * p.ldb * EB + C * 2); }
    const size_t kstep = 128;
    const size_t hstepA = (size_t)HALF * p.lda * EB, hstepB = (size_t)HALF * p.ldb * EB;
    const unsigned ldsw = (unsigned)wid * 1024u;
    const int aoff = EB == 2 ? lds_byte(wr * 64 + fr, fq * 8) : lds_byte(wr * 64 + fr, (fq & 1) * 16) + (fq >> 1) * 1024;
    const int boff = EB == 2 ? lds_byte(wc * 32 + fr, fq * 8) : lds_byte(wc * 32 + fr, (fq & 1) * 16) + (fq >> 1) * 1024;
    constexpr int KOFF = EB == 2 ? 1024 : 16;
    const int sc1 = 0x7f7f7f7f;
#define PG8_SA(b, h) (((b) * 2 + (h)) * HTB)
#define PG8_SB(b, h) ((4 + (b) * 2 + (h)) * HTB)
#define PG8_STAGE(bufoff, gbase, voff) do { _Pragma("unroll") for (int _i = 0; _i < 2; ++_i) \
        __builtin_amdgcn_global_load_lds((const unsigned*)((const char*)(gbase) + (voff)[_i]), (LAS unsigned*)(lds + (bufoff) + ldsw + _i * 8192), 16, 0, 0); } while (0)
#define PG8_LDA(dst, b, h) do { _Pragma("unroll") for (int m = 0; m < 4; ++m) _Pragma("unroll") for (int k = 0; k < 2; ++k) dst[m][k] = *(const LAS v4i*)(lds + PG8_SA(b, h) + aoff + m * 2048 + k * KOFF); } while (0)
#define PG8_LDB(dst, b, h) do { _Pragma("unroll") for (int n = 0; n < 2; ++n) _Pragma("unroll") for (int k = 0; k < 2; ++k) dst[n][k] = *(const LAS v4i*)(lds + PG8_SB(b, h) + boff + n * 2048 + k * KOFF); } while (0)
#define PG8_MMA(ai, bj, At, Bt) do { __builtin_amdgcn_s_setprio(1); _Pragma("unroll") for (int m = 0; m < 4; ++m) _Pragma("unroll") for (int n = 0; n < 2; ++n) { \
        if constexpr (EB == 2) { _Pragma("unroll") for (int k = 0; k < 2; ++k) acc[ai][bj][m][n] = __builtin_amdgcn_mfma_f32_16x16x32_bf16(__builtin_bit_cast(bf16x8, Bt[n][k]), __builtin_bit_cast(bf16x8, At[m][k]), acc[ai][bj][m][n], 0, 0, 0); } \
        else { const v8i bq_ = __builtin_shufflevector(Bt[n][0], Bt[n][1], 0, 1, 2, 3, 4, 5, 6, 7), aq_ = __builtin_shufflevector(At[m][0], At[m][1], 0, 1, 2, 3, 4, 5, 6, 7); \
            asm volatile("v_mfma_scale_f32_16x16x128_f8f6f4 %0, %1, %2, %0, %3, %3 op_sel_hi:[0,0,0]" : "+v"(acc[ai][bj][m][n]) : "v"(bq_), "v"(aq_), "v"(sc1)); } } \
        __builtin_amdgcn_s_setprio(0); } while (0)
#define PG8_WAIT_V(n) asm volatile("s_waitcnt vmcnt(" #n ")" ::: "memory")
#define PG8_WAIT_L(n) asm volatile("s_waitcnt lgkmcnt(" #n ")" ::: "memory")
#define PG8_BAR __builtin_amdgcn_s_barrier()
#define PG8_SCHED __builtin_amdgcn_sched_barrier(0)
    Unit cur, nxt; int ui = 0;
    if (!p.ord.next(0, cur)) return;
    f32x4 acc[2][2][4][2];
#pragma unroll
    for (int a = 0; a < 2; ++a)
#pragma unroll
        for (int b = 0; b < 2; ++b)
#pragma unroll
            for (int m = 0; m < 4; ++m)
#pragma unroll
                for (int n = 0; n < 2; ++n) acc[a][b][m][n] = (f32x4){0.f, 0.f, 0.f, 0.f};
    v4i At[4][2], B0[2][2], B1[2][2];
    const char* cA = p.a_base(cur); const char* cB = p.b_base(cur);
    PG8_STAGE(PG8_SB(0, 0), cB, voffB); PG8_STAGE(PG8_SB(0, 1), cB + hstepB, voffB); PG8_STAGE(PG8_SA(0, 0), cA, voffA); PG8_STAGE(PG8_SA(0, 1), cA + hstepA, voffA);
    if (wr == 1) PG8_BAR;
    PG8_WAIT_V(2); PG8_BAR;
    PG8_STAGE(PG8_SB(1, 0), cB + kstep, voffB); PG8_STAGE(PG8_SA(1, 0), cA + kstep, voffA); PG8_STAGE(PG8_SB(1, 1), cB + hstepB + kstep, voffB);
    PG8_WAIT_V(6); PG8_BAR;
    for (;;) {
        const bool has_next = p.ord.next(ui + 1, nxt);
        const char* nA = has_next ? p.a_base(nxt) : cA; const char* nB = has_next ? p.b_base(nxt) : cB;
        for (int t = 0; t < nt; t += 2) {
            const bool last = (t == nt - 2);
            const char* a1 = cA + (size_t)(t + 1) * kstep;
            const char* a2 = last ? nA : cA + (size_t)(t + 2) * kstep; const char* b2 = last ? nB : cB + (size_t)(t + 2) * kstep;
            const char* a3 = a2 + kstep; const char* b3 = b2 + kstep;
            PG8_LDB(B0, 0, 0); PG8_LDB(B1, 0, 1); PG8_SCHED; PG8_LDA(At, 0, 0); PG8_STAGE(PG8_SA(1, 1), a1 + hstepA, voffA);
            PG8_WAIT_V(8); PG8_WAIT_L(0); PG8_BAR; PG8_MMA(0, 0, At, B0); PG8_MMA(0, 1, At, B1); PG8_BAR; PG8_SCHED;
            PG8_LDA(At, 0, 1); PG8_STAGE(PG8_SB(0, 0), b2, voffB); PG8_STAGE(PG8_SB(0, 1), b2 + hstepB, voffB); PG8_STAGE(PG8_SA(0, 0), a2, voffA);
            PG8_WAIT_V(8); PG8_WAIT_L(0); PG8_BAR; PG8_MMA(1, 0, At, B0); PG8_MMA(1, 1, At, B1); PG8_BAR; PG8_SCHED;
            PG8_LDB(B0, 1, 0); PG8_LDB(B1, 1, 1); PG8_SCHED; PG8_LDA(At, 1, 0); PG8_STAGE(PG8_SA(0, 1), a2 + hstepA, voffA);
            PG8_WAIT_V(8); PG8_WAIT_L(0); PG8_BAR; PG8_MMA(0, 0, At, B0); PG8_MMA(0, 1, At, B1); PG8_BAR; PG8_SCHED;
            PG8_LDA(At, 1, 1); PG8_STAGE(PG8_SB(1, 0), b3, voffB); PG8_STAGE(PG8_SB(1, 1), b3 + hstepB, voffB); PG8_STAGE(PG8_SA(1, 0), a3, voffA);
            PG8_WAIT_V(8); PG8_WAIT_L(0); PG8_BAR; PG8_MMA(1, 0, At, B0); PG8_MMA(1, 1, At, B1); PG8_BAR; PG8_SCHED;
        }
        if (wr == 0) PG8_BAR;
        p.epi(acc, cur, wr, wc, fr, fq);
        if (!has_next) break;
#pragma unroll
        for (int a = 0; a < 2; ++a)
#pragma unroll
            for (int b = 0; b < 2; ++b)
#pragma unroll
                for (int m = 0; m < 4; ++m)
#pragma unroll
                    for (int n = 0; n < 2; ++n) acc[a][b][m][n] = (f32x4){0.f, 0.f, 0.f, 0.f};
        cur = nxt; cA = nA; cB = nB; ++ui;
        if (wr == 1) PG8_BAR;
    }
    PG8_WAIT_V(0);
    PG8_BAR;
#undef PG8_SA
#undef PG8_SB
#undef PG8_STAGE
#undef PG8_LDA
#undef PG8_LDB
#undef PG8_MMA
#undef PG8_WAIT_V
#undef PG8_WAIT_L
#undef PG8_BAR
#undef PG8_SCHED
}
}
using pg8::Unit;

struct ProbIn {
    static constexpr bool PERM = true; static constexpr int EB = 2;
    int K, lda, ldb; pg8::TileOrder ord; const char* A; const char* Bt; bf16* XR; bf16* GR; bf16* CQ; bf16* CKV; float* KR; float* SSQ;
    __device__ __forceinline__ const char* a_base(const Unit& u) const { return A + (size_t)u.pm * 256 * lda * 2; }
    __device__ __forceinline__ const char* b_base(const Unit& u) const { return Bt + (size_t)u.pn * 256 * ldb * 2; }
    __device__ __forceinline__ void epi(const f32x4 (&acc)[2][2][4][2], const Unit& u, int wr, int wc, int fr, int fq) const {
        const int pn = u.pn; const size_t rowt = (size_t)u.pm * 256;
        unsigned lrow = (unsigned)(wr * 64 + fr), lcol = (unsigned)(wc * 32 + 8 * fq); asm volatile("" : "+v"(lrow), "+v"(lcol));
        if (pn < 11) {
            bf16* dst; int ld;
            if (pn < 4) { dst = XR + rowt * 1024 + pn * 256; ld = 1024; } else if (pn < 8) { dst = GR + rowt * 1024 + (pn - 4) * 256; ld = 1024; }
            else if (pn < 10) { dst = CQ + rowt * 512 + (pn - 8) * 256; ld = 512; } else { dst = CKV + rowt * 256; ld = 256; }
            const unsigned loff = (lrow * (unsigned)ld + lcol) * 2u;
#pragma unroll
            for (int ai = 0; ai < 2; ++ai)
#pragma unroll
                for (int m = 0; m < 4; ++m) {
#pragma unroll
                    for (int bj = 0; bj < 2; ++bj) { const f32x4 v0 = acc[ai][bj][m][0], v1 = acc[ai][bj][m][1];
                        u32x4 w; w.x = pk2(v0[0], v0[1]); w.y = pk2(v0[2], v0[3]); w.z = pk2(v1[0], v1[1]); w.w = pk2(v1[2], v1[3]);
                        *(u32x4*)((char*)dst + ((size_t)(ai * 128 + m * 16) * ld + bj * 128) * 2 + loff) = w; } }
            if (pn >= 8) {
                float* sq = SSQ + rowt * 16 + (pn < 10 ? (pn - 8) * 4 : 8) + wc;
#pragma unroll
                for (int ai = 0; ai < 2; ++ai)
#pragma unroll
                    for (int m = 0; m < 4; ++m) { float ss = 0.f;
#pragma unroll
                        for (int bj = 0; bj < 2; ++bj)
#pragma unroll
                            for (int n = 0; n < 2; ++n) ss += dot4(acc[ai][bj][m][n], acc[ai][bj][m][n]);
                        ss += __shfl_xor(ss, 16); ss += __shfl_xor(ss, 32);
                        if (fq == 0) *(float*)((char*)sq + ((size_t)(ai * 128 + m * 16) * 16 + lrow * 16u) * 4) = ss; } }
        } else if (wc < 2) {
            float* kd = KR + rowt * 64; float* sq = SSQ + rowt * 16 + 12 + wc;
#pragma unroll
            for (int ai = 0; ai < 2; ++ai)
#pragma unroll
                for (int m = 0; m < 4; ++m) { const size_t ro = (size_t)(ai * 128 + m * 16);
                    *(f32x4*)((char*)kd + (ro * 64 + lrow * 64u + lcol) * 4) = acc[ai][0][m][0]; *(f32x4*)((char*)kd + (ro * 64 + lrow * 64u + lcol + 4) * 4) = acc[ai][0][m][1];
                    float ss = dot4(acc[ai][0][m][0], acc[ai][0][m][0]) + dot4(acc[ai][0][m][1], acc[ai][0][m][1]);
                    ss += __shfl_xor(ss, 16); ss += __shfl_xor(ss, 32);
                    if (fq == 0) *(float*)((char*)sq + (ro * 16 + lrow * 16u) * 4) = ss; }
        }
    }
};
struct ProbQ {
    static constexpr bool PERM = true; static constexpr int EB = 2;
    int K, lda, ldb; pg8::TileOrder ord; const char* A; const char* Bt; bf16* O;
    __device__ __forceinline__ const char* a_base(const Unit& u) const { return A + (size_t)u.pm * 256 * lda * 2; }
    __device__ __forceinline__ const char* b_base(const Unit& u) const { return Bt + (size_t)u.pn * 256 * ldb * 2; }
    __device__ __forceinline__ void epi(const f32x4 (&acc)[2][2][4][2], const Unit& u, int wr, int wc, int fr, int fq) const {
        unsigned loff = (unsigned)((wr * 64 + fr) * 1536 + wc * 32 + 8 * fq) * 2u; asm volatile("" : "+v"(loff));
        char* base = (char*)(O + (size_t)u.pm * 256 * 1536 + (size_t)u.pn * 256);
#pragma unroll
        for (int ai = 0; ai < 2; ++ai)
#pragma unroll
            for (int m = 0; m < 4; ++m)
#pragma unroll
                for (int bj = 0; bj < 2; ++bj) { const f32x4 v0 = acc[ai][bj][m][0], v1 = acc[ai][bj][m][1];
                    u32x4 w; w.x = pk2(v0[0], v0[1]); w.y = pk2(v0[2], v0[3]); w.z = pk2(v1[0], v1[1]); w.w = pk2(v1[2], v1[3]);
                    *(u32x4*)(base + ((size_t)(ai * 128 + m * 16) * 1536 + bj * 128) * 2 + loff) = w; }
    }
};
struct ProbKV {
    static constexpr bool PERM = true; static constexpr int EB = 2;
    int K, lda, ldb; pg8::TileOrder ord; const char* A; const char* Bt; bf16* Ko; bf16* Vo; const float* SSQ; float* RSTDK; const float* kn; LAS float* part;
    __device__ __forceinline__ const char* a_base(const Unit& u) const { return A + (size_t)u.pm * 256 * lda * 2; }
    __device__ __forceinline__ const char* b_base(const Unit& u) const { return Bt + (size_t)u.pn * 256 * ldb * 2; }
    __device__ __forceinline__ void epi(const f32x4 (&acc)[2][2][4][2], const Unit& u, int wr, int wc, int fr, int fq) const {
        const int h = u.pn; const int rowt = u.pm * 256; const bool lat = rowt < NL;
        const int b = lat ? (rowt >> 12) : ((rowt - NL) >> 8); const int pos0 = lat ? CTXL + (rowt & (SEQ - 1)) : ((rowt - NL) & (CTXL - 1));
        const size_t hrow0 = (size_t)(b * NH + h) * KVLEN + pos0;
        unsigned lrow = (unsigned)(wr * 64 + fr), lcol = (unsigned)(wc * 32 + 8 * fq); asm volatile("" : "+v"(lrow), "+v"(lcol));
        const char* sq = (const char*)(SSQ + (size_t)rowt * 16);
        float sc[2][4], kr2[2][4];
#pragma unroll
        for (int ai = 0; ai < 2; ++ai)
#pragma unroll
            for (int m = 0; m < 4; ++m) { const char* q = sq + ((size_t)(ai * 128 + m * 16) * 16 + lrow * 16u) * 4;
                const f32x4 pk = *(const f32x4*)(q + 32); const f32x2 pr = *(const f32x2*)(q + 48);
                sc[ai][m] = rsqrtf(((pk.x + pk.y) + (pk.z + pk.w)) * (1.f / KVRANK) + EPS); kr2[ai][m] = pr.x + pr.y;
                float ss = 0.f;
#pragma unroll
                for (int n = 0; n < 2; ++n) { const f32x4 y = acc[ai][0][m][n] * sc[ai][m]; ss += dot4(y, y); }
                ss += __shfl_xor(ss, 16); ss += __shfl_xor(ss, 32);
                if (fq == 0) part[(ai * 128 + m * 16 + lrow) * 4 + wc] = ss; }
        asm volatile("s_waitcnt lgkmcnt(0)" ::: "memory"); __builtin_amdgcn_s_barrier(); asm volatile("" ::: "memory");
        const f32x4 g0 = *(const f32x4*)((const char*)kn + lcol * 4), g1 = *(const f32x4*)((const char*)kn + lcol * 4 + 16);
        const unsigned frp = ((unsigned)fr & 3u) | (((unsigned)fr & 8u) >> 1) | (((unsigned)fr & 4u) << 1);
        unsigned voff = (unsigned)wr * 16384u + (4u * (frp >> 3) + (unsigned)wc) * 512u + (frp & 7u) * 64u + (unsigned)fq * 16u; asm volatile("" : "+v"(voff));
        const unsigned koff = (lrow * (unsigned)DQK + lcol) * 2u;
        char* kb = (char*)(Ko + hrow0 * DQK); char* vb = (char*)(Vo + hrow0 * DVH);
#pragma unroll
        for (int ai = 0; ai < 2; ++ai)
#pragma unroll
            for (int m = 0; m < 4; ++m) { const f32x4 pt = *(const LAS f32x4*)(part + (ai * 128 + m * 16 + lrow) * 4);
                const float tot = ((pt.x + pt.y) + (pt.z + pt.w)) + kr2[ai][m]; const float rk = rsqrtf(tot * (1.f / DQK) + EPS); const float f = sc[ai][m] * rk;
                const f32x4 k0 = acc[ai][0][m][0] * f * g0, k1 = acc[ai][0][m][1] * f * g1, v0 = acc[ai][1][m][0] * sc[ai][m], v1 = acc[ai][1][m][1] * sc[ai][m];
                u32x4 w; w.x = pk2(k0[0], k0[1]); w.y = pk2(k0[2], k0[3]); w.z = pk2(k1[0], k1[1]); w.w = pk2(k1[2], k1[3]);
                *(u32x4*)(kb + (size_t)(ai * 128 + m * 16) * DQK * 2 + koff) = w;
                w.x = pk2(v0[0], v0[1]); w.y = pk2(v0[2], v0[3]); w.z = pk2(v1[0], v1[1]); w.w = pk2(v1[2], v1[3]);
                *(u32x4*)(vb + (size_t)(ai * 2) * 16384 + m * 4096 + voff) = w;
                if (wc == 0 && fq == 0) RSTDK[(size_t)(rowt + ai * 128 + m * 16 + lrow) * 8 + h] = rk; }
    }
};
template <int CTRL> __device__ __forceinline__ float dppf(float old, float src) {
    return __builtin_bit_cast(float, __builtin_amdgcn_update_dpp(__builtin_bit_cast(int, old), __builtin_bit_cast(int, src), CTRL, 0xF, 0xF, false));
}
struct ProbGates {
    static constexpr bool PERM = false; static constexpr int EB = 2;
    int K, lda, ldb; pg8::TileOrder ord; const char* U; const char* Bt; char* HP; float* AGG; const float* ba; const float* bx; const float* lam;
    __device__ __forceinline__ const char* a_base(const Unit& u) const { return U + ((size_t)u.pm * 256 * 1024 + (size_t)(u.pn & 7) * 128) * 2; }
    __device__ __forceinline__ const char* b_base(const Unit& u) const { return Bt + (size_t)u.pn * 256 * 128 * 2; }
    template <bool BWD>
    __device__ __forceinline__ void epi_dir(const f32x4 (&acc)[2][2][4][2], const Unit& u, int wr, int wc, int fr, int fq) const {
        const int dir = BWD ? 1 : 0, gblk = u.pn & 7;
        unsigned coff = (unsigned)(wc * 32 + 4 * fq) * 4u;
        unsigned loffu = (unsigned)((wr * 64 + fr) * 1024 + wc * 32 + 4 * fq) * 2u;
        asm volatile("" : "+v"(coff), "+v"(loffu));
        const unsigned loffh = loffu * 2u;
        const size_t ubase = ((size_t)u.pm * 256 * 1024 + (size_t)gblk * 128);
        const char* Ub = U + ubase * 2;
        char* Hb = HP + ((size_t)dir * NR * 1024 + ubase) * 4;
        const char* bap = (const char*)(ba + dir * 1024 + gblk * 128); const char* bxp = (const char*)(bx + dir * 1024 + gblk * 128); const char* lmp = (const char*)(lam + dir * 1024 + gblk * 128);
        const int rowt = u.pm * 256; const int lane = fq * 16 + fr;
        const int bsel = (lane & 48) | (BWD ? 0 : 15);
#pragma unroll
        for (int ai = 0; ai < 2; ++ai) {
            const int r64 = rowt + ai * 128 + wr * 64; const int chunk = r64 < NL ? (r64 >> 12) * NCHUNK + 4 + ((r64 & (SEQ - 1)) >> 6) : ((r64 - NL) >> 8) * NCHUNK + (((r64 - NL) & (CTXL - 1)) >> 6);
#pragma unroll
            for (int n = 0; n < 2; ++n) {
                f32x4 A[4], H[4];
                const f32x4 bav = *(const f32x4*)(bap + n * 64 + coff), bxv = *(const f32x4*)(bxp + n * 64 + coff), lsl = *(const f32x4*)(lmp + n * 64 + coff);
#pragma unroll
                for (int m = 0; m < 4; ++m) {
                    const u32x2 uw = *(const u32x2*)(Ub + ((size_t)(ai * 128 + m * 16) * 1024 + n * 16) * 2 + loffu);
                    const float uv[4] = {bflo(uw.x), bfhi(uw.x), bflo(uw.y), bfhi(uw.y)};
#pragma unroll
                    for (int j = 0; j < 4; ++j) { const float r = sigmoid_fast(acc[ai][0][m][n][j] + bav[j]), ig = sigmoid_fast(acc[ai][1][m][n][j] + bxv[j]);
                        const float la = r * lsl[j]; A[m][j] = __expf(la); H[m][j] = __builtin_amdgcn_sqrtf(one_minus_exp(2.f * la)) * (ig * uv[j]); } }
#pragma unroll
                for (int m = 0; m < 4; ++m)
#pragma unroll
                    for (int j = 0; j < 4; ++j) { float av = A[m][j], hv = H[m][j];
#define SCAN_STEP(D) { const float ap = dppf<(BWD ? 0x100 : 0x110) + D>(1.f, av), hp = dppf<(BWD ? 0x100 : 0x110) + D>(0.f, hv); hv = fmaf(av, hp, hv); av = av * ap; }
                        SCAN_STEP(1) SCAN_STEP(2) SCAN_STEP(4) SCAN_STEP(8)
#undef SCAN_STEP
                        A[m][j] = av; H[m][j] = hv; }
#pragma unroll
                for (int j = 0; j < 4; ++j) { float Ar = 1.f, Hr = 0.f;
#pragma unroll
                    for (int mm = 0; mm < 4; ++mm) { const int m = BWD ? 3 - mm : mm;
                        H[m][j] = fmaf(A[m][j], Hr, H[m][j]); A[m][j] = A[m][j] * Ar;
                        if (mm < 3) { Ar = __shfl(A[m][j], bsel); Hr = __shfl(H[m][j], bsel); } } }
#pragma unroll
                for (int m = 0; m < 4; ++m) { u32x4 w; w.x = pk2(H[m][0], H[m][1]); w.y = pk2(H[m][2], H[m][3]); w.z = pk2(A[m][0], A[m][1]); w.w = pk2(A[m][2], A[m][3]);
                    *(u32x4*)(Hb + ((size_t)(ai * 128 + m * 16) * 1024 + n * 16) * 4 + loffh) = w; }
                constexpr int me = BWD ? 0 : 3;
                if (fr == (BWD ? 0 : 15)) { const size_t o = (size_t)chunk * 1024 + gblk * 128 + n * 16;
                    *(f32x4*)((char*)(AGG + (size_t)(dir * 2 + 0) * NB * NCHUNK * 1024 + o) + coff) = A[me];
                    *(f32x4*)((char*)(AGG + (size_t)(dir * 2 + 1) * NB * NCHUNK * 1024 + o) + coff) = H[me]; }
                asm volatile("" ::: "memory"); __builtin_amdgcn_sched_barrier(0);
            }
        }
    }
    __device__ __forceinline__ void epi(const f32x4 (&acc)[2][2][4][2], const Unit& u, int wr, int wc, int fr, int fq) const {
        if ((u.pn >> 3) == 0) epi_dir<false>(acc, u, wr, wc, fr, fq); else epi_dir<true>(acc, u, wr, wc, fr, fq);
    }
};
struct ProbMixer {
    static constexpr bool PERM = true; static constexpr int EB = 2;
    int K, lda, ldb; pg8::TileOrder ord; const char* A; const char* Bt; const float* xl; const float* xc; const bf16* x1; bf16* XM; const float* modv; int pm0;
    __device__ __forceinline__ const char* a_base(const Unit& u) const { return A + (size_t)(u.pm + pm0) * 256 * 2048 * 2; }
    __device__ __forceinline__ const char* b_base(const Unit& u) const { return Bt + (size_t)u.pn * 256 * 2048 * 2; }
    __device__ __forceinline__ void epi(const f32x4 (&acc)[2][2][4][2], const Unit& u, int wr, int wc, int fr, int fq) const {
        const int rowt = (u.pm + pm0) * 256; const int mb = rowt < NL ? (rowt >> 12) : 4;
        const bool f32in = xl != nullptr;
        const char* xin = f32in ? (const char*)(rowt < NL ? xl + (size_t)rowt * DM : xc + (size_t)(rowt - NL) * DM) + (size_t)u.pn * 1024 : (const char*)(x1 + (size_t)rowt * DM) + (size_t)u.pn * 512;
        const char* g1 = (const char*)(modv + mb * NMODW + 2 * DM) + (size_t)u.pn * 1024;
        char* xo = (char*)(XM + (size_t)rowt * DM) + (size_t)u.pn * 512;
        unsigned lcol = (unsigned)(wc * 32 + 8 * fq), lrow = (unsigned)(wr * 64 + fr); asm volatile("" : "+v"(lcol), "+v"(lrow));
        const unsigned loff4 = (lrow * DM + lcol) * 4u, loff2 = (lrow * DM + lcol) * 2u;
#pragma unroll
        for (int ai = 0; ai < 2; ++ai)
#pragma unroll
            for (int m = 0; m < 4; ++m) { const size_t ro = (size_t)(ai * 128 + m * 16) * DM;
#pragma unroll
                for (int bj = 0; bj < 2; ++bj) { const int cofs = bj * 128;
                    const f32x4 g0 = *(const f32x4*)(g1 + cofs * 4 + lcol * 4), g1v = *(const f32x4*)(g1 + cofs * 4 + lcol * 4 + 16);
                    f32x4 x0, x1v;
                    if (f32in) { x0 = *(const f32x4*)(xin + (ro + cofs) * 4 + loff4); x1v = *(const f32x4*)(xin + (ro + cofs) * 4 + loff4 + 16); }
                    else { const u32x4 w = *(const u32x4*)(xin + (ro + cofs) * 2 + loff2); x0 = (f32x4){bflo(w.x), bfhi(w.x), bflo(w.y), bfhi(w.y)}; x1v = (f32x4){bflo(w.z), bfhi(w.z), bflo(w.w), bfhi(w.w)}; }
                    const f32x4 o0 = x0 + g0 * acc[ai][bj][m][0], o1 = x1v + g1v * acc[ai][bj][m][1];
                    u32x4 ow; ow.x = pk2(o0[0], o0[1]); ow.y = pk2(o0[2], o0[3]); ow.z = pk2(o1[0], o1[1]); ow.w = pk2(o1[2], o1[3]);
                    *(u32x4*)(xo + (ro + cofs) * 2 + loff2) = ow; }
                asm volatile("" ::: "memory"); }
    }
};
struct ProbGateUp {
    static constexpr bool PERM = true; static constexpr int EB = 1;
    int K, lda, ldb; pg8::TileOrder ord; const char* XG; const char* Bt; unsigned char* ACT; int tpe;
    __device__ __forceinline__ const char* a_base(const Unit& u) const { const int e = u.pm / tpe, t = u.pm - e * tpe; return XG + ((size_t)e * EROWS + (size_t)t * 256) * 2048; }
    __device__ __forceinline__ const char* b_base(const Unit& u) const { const int e = u.pm / tpe; return Bt + ((size_t)e * 4096 + (size_t)u.pn * 256) * 2048; }
    __device__ __forceinline__ void epi(const f32x4 (&acc)[2][2][4][2], const Unit& u, int wr, int wc, int fr, int fq) const {
        const int e = u.pm / tpe, t = u.pm - e * tpe;
        char* base = (char*)(ACT + ((size_t)e * EROWS + (size_t)t * 256) * 2048 + (size_t)u.pn * 128);
        unsigned loff = (unsigned)((wr * 64 + fr) * 2048 + wc * 32 + 8 * fq); asm volatile("" : "+v"(loff));
        constexpr float S = 1.f / W8_SCALE;
#pragma unroll
        for (int ai = 0; ai < 2; ++ai)
#pragma unroll
            for (int m = 0; m < 4; ++m) {
                float o[8];
#pragma unroll
                for (int n = 0; n < 2; ++n)
#pragma unroll
                    for (int j = 0; j < 4; ++j) o[n * 4 + j] = silu_fast(acc[ai][0][m][n][j] * S) * (acc[ai][1][m][n][j] * S);
                u32x2 w; w.x = pk4_fp8(o[0], o[1], o[2], o[3]); w.y = pk4_fp8(o[4], o[5], o[6], o[7]);
                *(u32x2*)(base + (size_t)(ai * 128 + m * 16) * 2048 + loff) = w; }
    }
};
struct ProbDown {
    static constexpr bool PERM = true; static constexpr int EB = 1;
    int K, lda, ldb; pg8::TileOrder ord; const char* ACT; const char* Bt; bf16* YE; const float* gatev; int tpe;
    __device__ __forceinline__ const char* a_base(const Unit& u) const { const int e = u.pm / tpe, t = u.pm - e * tpe; return ACT + ((size_t)e * EROWS + (size_t)t * 256) * 2048; }
    __device__ __forceinline__ const char* b_base(const Unit& u) const { const int e = u.pm / tpe; return Bt + ((size_t)e * 2048 + (size_t)u.pn * 256) * 2048; }
    __device__ __forceinline__ void epi(const f32x4 (&acc)[2][2][4][2], const Unit& u, int wr, int wc, int fr, int fq) const {
        const int e = u.pm / tpe, t = u.pm - e * tpe; const size_t rowt = (size_t)e * EROWS + (size_t)t * 256;
        char* base = (char*)(YE + rowt * 2048 + (size_t)u.pn * 256); const char* gp = (const char*)(gatev + rowt);
        unsigned loff = (unsigned)((wr * 64 + fr) * 2048 + wc * 32 + 8 * fq) * 2u, goff = (unsigned)(wr * 64 + fr) * 4u; asm volatile("" : "+v"(loff), "+v"(goff));
#pragma unroll
        for (int ai = 0; ai < 2; ++ai)
#pragma unroll
            for (int m = 0; m < 4; ++m) { const float g = *(const float*)(gp + (ai * 128 + m * 16) * 4 + goff) * (1.f / W8_SCALE);
#pragma unroll
                for (int bj = 0; bj < 2; ++bj) { const f32x4 v0 = acc[ai][bj][m][0] * g, v1 = acc[ai][bj][m][1] * g;
                    u32x4 w; w.x = pk2(v0[0], v0[1]); w.y = pk2(v0[2], v0[3]); w.z = pk2(v1[0], v1[1]); w.w = pk2(v1[2], v1[3]);
                    *(u32x4*)(base + ((size_t)(ai * 128 + m * 16) * 2048 + bj * 128) * 2 + loff) = w; } }
    }
};

namespace att {
constexpr int NW = 8, QBLK = 32, KVBLK = 64;
constexpr float SCALE = 0.07216878364870322f;
constexpr float THR = 8.f;
constexpr int KROWB = 400;
constexpr int SHM_V = KVBLK * DVH * 2, SHM_K = KVBLK * KROWB;
constexpr int NQR = 12;
constexpr int QROWB = (12 - NQR) * 32 + 16;
constexpr int LDS_V = 0, LDS_K = 2 * SHM_V, LDS_WS = 2 * SHM_V + 2 * SHM_K, LDS_QR = LDS_WS + NW * 64 * 4, LDS_TOTAL = LDS_QR + 256 * QROWB;
static_assert(LDS_TOTAL <= LDS_MISC, "attention LDS");
#define SBAR() __builtin_amdgcn_sched_barrier(0)
__device__ __forceinline__ int crow(int r, int hi) { return (r & 3) + 8 * (r >> 2) + 4 * hi; }
__device__ __forceinline__ unsigned cvtpk(float lo, float hi) { unsigned r; asm volatile("v_cvt_pk_bf16_f32 %0, %1, %2" : "=v"(r) : "v"(lo), "v"(hi)); return r; }
constexpr float QSC = SCALE * 1.4426950408889634f;
constexpr float THRL = THR * 1.4426950408889634f;
__device__ __forceinline__ void partialSM(f32x16& p0, f32x16& p1, f32x16& negm, float& l_reg, f32x16* o, LAS float* al_l, int r32, int hi) {
    float ma = fmaxf(fmaxf(p0[0], p0[1]), p0[2]), mb = fmaxf(fmaxf(p1[0], p1[1]), p1[2]);
#pragma unroll
    for (int r = 3; r + 1 < 16; r += 2) { ma = fmaxf(fmaxf(ma, p0[r]), p0[r + 1]); mb = fmaxf(fmaxf(mb, p1[r]), p1[r + 1]); }
    float pmax = fmaxf(fmaxf(ma, mb), fmaxf(p0[15], p1[15]));
    { auto rr = __builtin_amdgcn_permlane32_swap(__float_as_uint(pmax), __float_as_uint(pmax), false, false);
      pmax = fmaxf(__uint_as_float(rr[0]), __uint_as_float(rr[1])); }
    if (__builtin_expect(!__all(pmax <= THRL), 0)) {
        const float d = fmaxf(pmax, 0.f), alpha = __builtin_amdgcn_exp2f(-d), nm = negm[0] - d;
        l_reg *= alpha;
#pragma unroll
        for (int r = 0; r < 16; ++r) { p0[r] -= d; p1[r] -= d; negm[r] = nm; }
        if (hi == 0) al_l[r32] = alpha;
        asm volatile("s_waitcnt lgkmcnt(0)" ::: "memory");
#pragma unroll
        for (int dd = 0; dd < 4; ++dd)
#pragma unroll
            for (int r = 0; r < 16; ++r) o[dd][r] *= al_l[crow(r, hi)];
    }
#pragma unroll
    for (int r = 0; r < 16; ++r) p0[r] = __builtin_amdgcn_exp2f(p0[r]);
}
__device__ __forceinline__ void partialSM_first(f32x16& p0, f32x16& p1, f32x16& negm) {
    float pmax = p0[0];
#pragma unroll
    for (int r = 1; r < 16; ++r) pmax = fmaxf(pmax, p0[r]);
#pragma unroll
    for (int r = 0; r < 16; ++r) pmax = fmaxf(pmax, p1[r]);
    { auto rr = __builtin_amdgcn_permlane32_swap(__float_as_uint(pmax), __float_as_uint(pmax), false, false);
      pmax = fmaxf(__uint_as_float(rr[0]), __uint_as_float(rr[1])); }
#pragma unroll
    for (int r = 0; r < 16; ++r) { p0[r] -= pmax; p1[r] -= pmax; negm[r] = -pmax; }
#pragma unroll
    for (int r = 0; r < 16; ++r) p0[r] = __builtin_amdgcn_exp2f(p0[r]);
}
__device__ __forceinline__ void finishSM(f32x16& p0, f32x16& p1, float& l_reg, bf16x8& pa0, bf16x8& pa1, bf16x8& pa2, bf16x8& pa3) {
#pragma unroll
    for (int r = 0; r < 16; ++r) p1[r] = __builtin_amdgcn_exp2f(p1[r]);
    float ps = 0;
#pragma unroll
    for (int r = 0; r < 16; ++r) ps += p0[r];
#pragma unroll
    for (int r = 0; r < 16; ++r) ps += p1[r];
    { auto rr = __builtin_amdgcn_permlane32_swap(__float_as_uint(ps), __float_as_uint(ps), false, false);
      ps = __uint_as_float(rr[0]) + __uint_as_float(rr[1]); }
    l_reg += ps;
#define PK4(P, BASE, OUT) do { unsigned a0 = cvtpk(P[BASE + 0], P[BASE + 1]), a1 = cvtpk(P[BASE + 2], P[BASE + 3]);   \
    unsigned b0 = cvtpk(P[BASE + 4], P[BASE + 5]), b1 = cvtpk(P[BASE + 6], P[BASE + 7]);                              \
    auto r0 = __builtin_amdgcn_permlane32_swap(a0, b0, false, false); auto r1 = __builtin_amdgcn_permlane32_swap(a1, b1, false, false); \
    u32x4 w = {r0[0], r1[0], r0[1], r1[1]}; OUT = *reinterpret_cast<bf16x8*>(&w); } while (0)
    PK4(p0, 0, pa0); PK4(p0, 8, pa1); PK4(p1, 0, pa2); PK4(p1, 8, pa3);
#undef PK4
}
__device__ __forceinline__ void qkt(f32x16& p0, f32x16& p1, const LAS char* Kl, const bf16x8* qr, const LAS char* Ql, const f32x16& init) {
#pragma unroll
    for (int d0 = 0; d0 < 12; ++d0) {
        const bf16x8 b0 = *reinterpret_cast<const LAS bf16x8*>(Kl + d0 * 32);
        const bf16x8 b1 = *reinterpret_cast<const LAS bf16x8*>(Kl + 32 * KROWB + d0 * 32);
        const bf16x8 q = d0 < NQR ? qr[d0 < NQR ? d0 : 0] : *reinterpret_cast<const LAS bf16x8*>(Ql + (d0 - NQR) * 32);
        p0 = __builtin_amdgcn_mfma_f32_32x32x16_bf16(b0, q, d0 == 0 ? init : p0, 0, 0, 0);
        p1 = __builtin_amdgcn_mfma_f32_32x32x16_bf16(b1, q, d0 == 0 ? init : p1, 0, 0, 0); }
}
__device__ __forceinline__ int v_st(int k, int c) { const int kk = (k & ~0xC) | ((k & 4) << 1) | ((k & 8) >> 1); return ((kk >> 3) * 4 + (c >> 5)) * 512 + ((kk & 7) * 32 + (c & 31)) * 2; }
__device__ __forceinline__ int v_rd_base(int lane) { return ((lane & 3) << 3) | (((lane >> 2) & 3) << 6) | (((lane >> 4) & 1) << 5) | (((lane >> 5) & 1) << 8); }
constexpr int v_rd_off(int d0, int ks, int half) { return d0 * 512 + ks * 4096 + half * 2048; }
template <int OFF> __device__ __forceinline__ s16x4 tr_read(int vb) {
    s16x4 r; asm volatile("ds_read_b64_tr_b16 %0, %1 offset:%2" : "=&v"(r) : "v"(vb), "i"(OFF) : "memory"); return r;
}
template <int D0> __device__ __forceinline__ void pv_one(f32x16& od, int vb, bf16x8 pa0, bf16x8 pa1, bf16x8 pa2, bf16x8 pa3) {
    const s16x4 l0 = tr_read<v_rd_off(D0, 0, 0)>(vb), h0 = tr_read<v_rd_off(D0, 0, 1)>(vb), l1 = tr_read<v_rd_off(D0, 1, 0)>(vb), h1 = tr_read<v_rd_off(D0, 1, 1)>(vb);
    const s16x4 l2 = tr_read<v_rd_off(D0, 2, 0)>(vb), h2 = tr_read<v_rd_off(D0, 2, 1)>(vb), l3 = tr_read<v_rd_off(D0, 3, 0)>(vb), h3 = tr_read<v_rd_off(D0, 3, 1)>(vb);
    asm volatile("s_waitcnt lgkmcnt(0)" ::: "memory"); SBAR();
#define PK(L, H) (bf16x8){L[0], L[1], L[2], L[3], H[0], H[1], H[2], H[3]}
    od = __builtin_amdgcn_mfma_f32_32x32x16_bf16(pa0, PK(l0, h0), od, 0, 0, 0);
    od = __builtin_amdgcn_mfma_f32_32x32x16_bf16(pa1, PK(l1, h1), od, 0, 0, 0);
    od = __builtin_amdgcn_mfma_f32_32x32x16_bf16(pa2, PK(l2, h2), od, 0, 0, 0);
    od = __builtin_amdgcn_mfma_f32_32x32x16_bf16(pa3, PK(l3, h3), od, 0, 0, 0);
#undef PK
}
__device__ __forceinline__ void pv_d0(f32x16* o, int vb, bf16x8 pa0, bf16x8 pa1, bf16x8 pa2, bf16x8 pa3) {
    pv_one<0>(o[0], vb, pa0, pa1, pa2, pa3); pv_one<1>(o[1], vb, pa0, pa1, pa2, pa3); pv_one<2>(o[2], vb, pa0, pa1, pa2, pa3); pv_one<3>(o[3], vb, pa0, pa1, pa2, pa3);
}
__device__ __forceinline__ void attn_unit(const bf16* __restrict__ Qraw, const float* __restrict__ ssq, const float* __restrict__ qn, int t0, const bf16* __restrict__ Kh, const bf16* __restrict__ Vh, bf16* __restrict__ Ob, int seq, LAS char* lds, int tid) {
    const int wid = __builtin_amdgcn_readfirstlane(tid >> 6), lane = tid & 63, r32 = lane & 31, hi = lane >> 5;
    LAS char* V_lds = lds + LDS_V; LAS char* K_lds = lds + LDS_K;
    LAS float* ws = (LAS float*)(lds + LDS_WS) + wid * 64; LAS float* li_l = ws; LAS float* al_l = ws + 32;
    float l_reg = 0; f32x16 o[4] = {}; bf16x8 qr[NQR];
    const char* Qw = (const char*)Qraw + (size_t)(wid * QBLK) * 1536 * 2; const unsigned qoff = (unsigned)(r32 * 1536 + hi * 8) * 2u;
    LAS char* Ql = lds + LDS_QR + (wid * QBLK + r32) * QROWB + hi * 16;
    {
        bf16x8 raw[12];
        unsigned gq = (unsigned)hi * 32u; asm volatile("" : "+v"(gq));
        const char* qnb = (const char*)qn;
#pragma unroll
        for (int d0 = 0; d0 < 12; ++d0) raw[d0] = *reinterpret_cast<const bf16x8*>(Qw + d0 * 32 + qoff);
        const float* sp = ssq + (size_t)(wid * QBLK + r32) * 16; const f32x4 p0 = *(const f32x4*)sp, p1 = *(const f32x4*)(sp + 4);
        const float sq = rsqrtf((((p0.x + p0.y) + (p0.z + p0.w)) + ((p1.x + p1.y) + (p1.z + p1.w))) * (1.f / QRANK) + EPS);
        float ss = 0.f;
#pragma unroll
        for (int d0 = 0; d0 < 12; ++d0)
#pragma unroll
            for (int e = 0; e < 8; ++e) { const float y = bf2f((unsigned short)raw[d0][e]) * sq; ss = fmaf(y, y, ss); }
        ss += __shfl_xor(ss, 32);
        const float f = sq * rsqrtf(ss * (1.f / DQK) + EPS) * QSC;
#pragma unroll
        for (int d0 = 0; d0 < 8; ++d0) { const f32x4 g0 = *(const f32x4*)(qnb + d0 * 64 + gq), g1 = *(const f32x4*)(qnb + d0 * 64 + 16 + gq);
            u32x4 w; w.x = pk2(bf2f((unsigned short)raw[d0][0]) * f * g0.x, bf2f((unsigned short)raw[d0][1]) * f * g0.y); w.y = pk2(bf2f((unsigned short)raw[d0][2]) * f * g0.z, bf2f((unsigned short)raw[d0][3]) * f * g0.w);
            w.z = pk2(bf2f((unsigned short)raw[d0][4]) * f * g1.x, bf2f((unsigned short)raw[d0][5]) * f * g1.y); w.w = pk2(bf2f((unsigned short)raw[d0][6]) * f * g1.z, bf2f((unsigned short)raw[d0][7]) * f * g1.w);
            if (d0 < NQR) qr[d0 < NQR ? d0 : 0] = __builtin_bit_cast(bf16x8, w); else *reinterpret_cast<LAS bf16x8*>(Ql + (d0 - NQR) * 32) = __builtin_bit_cast(bf16x8, w); }
        const int t = t0 + wid * QBLK + r32; const float pr = (float)(t >> 6), pc = (float)(t & 63);
#pragma unroll
        for (int ax = 0; ax < 2; ++ax) {
            float x1[8], x2[8];
            const f32x4 ga0 = *(const f32x4*)(qnb + (128 + 32 * ax) * 4 + gq), ga1 = *(const f32x4*)(qnb + (128 + 32 * ax) * 4 + 16 + gq), gb0 = *(const f32x4*)(qnb + (144 + 32 * ax) * 4 + gq), gb1 = *(const f32x4*)(qnb + (144 + 32 * ax) * 4 + 16 + gq);
            const float ga[8] = {ga0.x, ga0.y, ga0.z, ga0.w, ga1.x, ga1.y, ga1.z, ga1.w}, gb[8] = {gb0.x, gb0.y, gb0.z, gb0.w, gb1.x, gb1.y, gb1.z, gb1.w};
#pragma unroll
            for (int e = 0; e < 8; ++e) { x1[e] = bf2f((unsigned short)raw[8 + 2 * ax][e]) * f * ga[e]; x2[e] = bf2f((unsigned short)raw[9 + 2 * ax][e]) * f * gb[e]; }
            if (t0 >= 0) { const float p = ax ? pc : pr;
#pragma unroll
                for (int e = 0; e < 8; ++e) { const float inv = __builtin_amdgcn_exp2f(-(float)((gq >> 2) + e) * (13.287712379549449f / 16.f)); float sn, cs; __sincosf(p * inv, &sn, &cs);
                    const float y1 = x1[e] * cs - x2[e] * sn, y2 = x2[e] * cs + x1[e] * sn; x1[e] = y1; x2[e] = y2; } }
            u32x4 w; w.x = pk2(x1[0], x1[1]); w.y = pk2(x1[2], x1[3]); w.z = pk2(x1[4], x1[5]); w.w = pk2(x1[6], x1[7]);
            if (8 + 2 * ax < NQR) qr[8 + 2 * ax < NQR ? 8 + 2 * ax : 0] = __builtin_bit_cast(bf16x8, w); else *reinterpret_cast<LAS bf16x8*>(Ql + (8 + 2 * ax >= NQR ? 8 - NQR + 2 * ax : 0) * 32) = __builtin_bit_cast(bf16x8, w);
            w.x = pk2(x2[0], x2[1]); w.y = pk2(x2[2], x2[3]); w.z = pk2(x2[4], x2[5]); w.w = pk2(x2[6], x2[7]);
            if (9 + 2 * ax < NQR) qr[9 + 2 * ax < NQR ? 9 + 2 * ax : 0] = __builtin_bit_cast(bf16x8, w); else *reinterpret_cast<LAS bf16x8*>(Ql + (9 + 2 * ax >= NQR ? 9 - NQR + 2 * ax : 0) * 32) = __builtin_bit_cast(bf16x8, w); }
    }
#define KOFS(j_) ({ const int p_ = 64 * (wid + 8 * (j_)) + lane, row_ = p_ / 25; int cc_ = p_ - row_ * 25; if (cc_ == 24) cc_ = 0; (unsigned)((row_ < 64 ? row_ : 0) * (DQK * 2) + cc_ * 16); })
    const unsigned ko0 = KOFS(0), ko1 = KOFS(1), ko2 = KOFS(2), ko3 = KOFS(3);
#undef KOFS
    const unsigned vo0 = (unsigned)(wid * 1024 + lane * 16);
    const int vb0 = (int)(unsigned)(size_t)V_lds + v_rd_base(lane);
    const LAS char* Kl0 = K_lds + r32 * KROWB + hi * 16;
#define DMA_V(k0, b) do { const char* vb_ = (const char*)Vh + (size_t)(k0) * (DVH * 2); LAS char* ld_ = V_lds + (b) * SHM_V + wid * 1024; \
    unsigned a0_ = vo0; asm volatile("" : "+v"(a0_)); \
    __builtin_amdgcn_global_load_lds((const unsigned*)(vb_ + a0_), (LAS unsigned*)(ld_), 16, 0, 0); __builtin_amdgcn_global_load_lds((const unsigned*)(vb_ + 8192 + a0_), (LAS unsigned*)(ld_ + 8192), 16, 0, 0); } while (0)
#define DMA_K(k0, b) do { const char* kb_ = (const char*)Kh + (size_t)(k0) * (DQK * 2); LAS char* ld_ = K_lds + (b) * SHM_K + wid * 1024; \
    unsigned a0_ = ko0, a1_ = ko1, a2_ = ko2; asm volatile("" : "+v"(a0_), "+v"(a1_), "+v"(a2_));     \
    __builtin_amdgcn_global_load_lds((const unsigned*)(kb_ + a0_), (LAS unsigned*)(ld_), 16, 0, 0); __builtin_amdgcn_global_load_lds((const unsigned*)(kb_ + a1_), (LAS unsigned*)(ld_ + 8192), 16, 0, 0); \
    __builtin_amdgcn_global_load_lds((const unsigned*)(kb_ + a2_), (LAS unsigned*)(ld_ + 16384), 16, 0, 0); \
    if (wid == 0) { unsigned a3_ = ko3; asm volatile("" : "+v"(a3_)); __builtin_amdgcn_global_load_lds((const unsigned*)(kb_ + a3_), (LAS unsigned*)(ld_ + 24576), 16, 0, 0); } } while (0)
#define KWAIT_BAR() do { asm volatile("s_waitcnt vmcnt(0)" ::: "memory"); __syncthreads(); } while (0)
#define SWAIT() asm volatile("s_waitcnt vmcnt(0)" ::: "memory")
#define RESC(a) do { if (__any((a) < 1.f)) { if (hi == 0) al_l[r32] = (a); asm volatile("s_waitcnt lgkmcnt(0)" ::: "memory"); \
    _Pragma("unroll") for (int d = 0; d < 4; ++d) _Pragma("unroll") for (int r = 0; r < 16; ++r) o[d][r] *= al_l[crow(r, hi)]; } } while (0)
    f32x16 pA0, pA1, pB0, pB1, negm; bf16x8 pa0, pa1, pa2, pa3; const int NT = seq / KVBLK;
    DMA_K(0, 0); DMA_K(KVBLK, 1); DMA_V(0, 0); KWAIT_BAR();
    qkt(pA0, pA1, Kl0, qr, Ql, f32x16{}); partialSM_first(pA0, pA1, negm);
    __syncthreads();
    for (int h = 1; h + 1 < NT; h += 2) {
        DMA_V(h * KVBLK, 1); DMA_K((h + 1) * KVBLK, 0);
        SBAR(); qkt(pB0, pB1, Kl0 + SHM_K, qr, Ql, negm);
        finishSM(pA0, pA1, l_reg, pa0, pa1, pa2, pa3); SBAR();
        pv_d0(o, vb0, pa0, pa1, pa2, pa3); partialSM(pB0, pB1, negm, l_reg, o, al_l, r32, hi);
        KWAIT_BAR();
        DMA_V((h + 1) * KVBLK, 0); DMA_K((h + 2) * KVBLK, 1);
        SBAR(); qkt(pA0, pA1, Kl0, qr, Ql, negm);
        finishSM(pB0, pB1, l_reg, pa0, pa1, pa2, pa3); SBAR();
        pv_d0(o, vb0 + SHM_V, pa0, pa1, pa2, pa3); partialSM(pA0, pA1, negm, l_reg, o, al_l, r32, hi);
        KWAIT_BAR();
    }
    DMA_V((NT - 1) * KVBLK, 1);
    SBAR(); qkt(pB0, pB1, Kl0 + SHM_K, qr, Ql, negm);
    finishSM(pA0, pA1, l_reg, pa0, pa1, pa2, pa3); SBAR();
    pv_d0(o, vb0, pa0, pa1, pa2, pa3); partialSM(pB0, pB1, negm, l_reg, o, al_l, r32, hi);
    KWAIT_BAR();
    finishSM(pB0, pB1, l_reg, pa0, pa1, pa2, pa3); SBAR();
    pv_d0(o, vb0 + SHM_V, pa0, pa1, pa2, pa3);
    if (hi == 0) li_l[r32] = l_reg; asm volatile("s_waitcnt lgkmcnt(0)" ::: "memory");
    float rli[16];
#pragma unroll
    for (int r = 0; r < 16; ++r) rli[r] = __builtin_amdgcn_rcpf(li_l[crow(r, hi)]);
    char* Ow = (char*)Ob + (size_t)(wid * QBLK) * DM * 2; const unsigned ooff = (unsigned)(4 * hi * DM + r32) * 2u;
#pragma unroll
    for (int r = 0; r < 16; ++r) {
#pragma unroll
        for (int d0 = 0; d0 < 4; ++d0) *(bf16*)(Ow + (((r & 3) + 8 * (r >> 2)) * DM + d0 * 32) * 2 + ooff) = (bf16)f2bf(o[d0][r] * rli[r]); }
    __syncthreads();
#undef DMA_K
#undef KWAIT_BAR
#undef DMA_V
#undef SWAIT
#undef RESC
}
}

#ifndef DUP_MASK
#define DUP_MASK 0
#endif
#define NREP(j) (1 + ((DUP_MASK >> (j)) & 1))
struct Ctx { LAS unsigned char* lds; int tid, lane, wave, bid, G; };
#define WSP(T, off) ((T*)(GAS T*)(wsb + (off)))
#define INP(i) ((const float*)(const GAS float*)a.in[i])
#define WSW(T, off, l) WSP(T, WS_WSET + (size_t)(l) * WSET_STRIDE + (off))
#define PHASE_BEGIN() Ctx c = c0; { int t_ = c0.tid; asm volatile("" : "+v"(t_)); c.tid = t_; c.lane = t_ & 63; c.wave = __builtin_amdgcn_readfirstlane(t_ >> 6); } \
    GAS unsigned char* wsb = (GAS unsigned char*)a.ws; asm volatile("" : "+s"(wsb));

__device__ __forceinline__ void convert_tile(const Args& a, GAS unsigned char* wsb, int l, int t, LAS float* scr, int lane);
__device__ __forceinline__ void convert_misc(const Args& a, GAS unsigned char* wsb, int l, int gt, int NGT);
__device__ __forceinline__ void mod_items(const Args& a, const Ctx& c0, int l) {
    PHASE_BEGIN();
    __syncthreads();
    LAS float* sc = (LAS float*)c.lds;
    LAS float* red = (LAS float*)(c.lds + 40960);
    for (int i = c.tid; i < 5 * DM; i += 512) { const int r = i >> 11, k = i & 2047; const float v = r < 4 ? INP(1)[r * DM + k] : INP(3)[k]; sc[i] = silu_(v); }
    __syncthreads();
    const int cl = c.tid & 15, kg = c.tid >> 4;
    float* modv = WSP(float, WS_MODV);
    for (int cb = c.bid; cb < 192; cb += c.G) {
        const float* w = INP(4) + (size_t)l * DM * NMODW + cb * 64 + cl * 4;
        f32x4 acc[5];
#pragma unroll
        for (int r = 0; r < 5; ++r) acc[r] = (f32x4){0.f, 0.f, 0.f, 0.f};
#pragma unroll 4
        for (int k = kg; k < DM; k += 32) { const f32x4 wv = *(const f32x4*)(w + (size_t)k * NMODW);
#pragma unroll
            for (int r = 0; r < 5; ++r) acc[r] += sc[r * DM + k] * wv; }
#pragma unroll
        for (int r = 0; r < 5; ++r) *(LAS f32x4*)(red + (kg * 5 + r) * 64 + cl * 4) = acc[r];
        __syncthreads();
        if (c.tid < 320) { const int r = c.tid >> 6, cc = c.tid & 63; float s = 0.f;
            for (int g = 0; g < 32; ++g) s += red[(g * 5 + r) * 64 + cc];
            modv[(size_t)(l * 5 + r) * NMODW + cb * 64 + cc] = s + INP(5)[(size_t)l * NMODW + cb * 64 + cc]; }
        __syncthreads();
    }
}
__device__ __forceinline__ void phase_mod(const Args& a, const Ctx& c0) {
    { PHASE_BEGIN();
      LAS float* scr = (LAS float*)(c.lds + c.wave * 16640); for (int t = c.bid * 8 + c.wave; t < T_SMALL; t += c.G * 8) convert_tile(a, wsb, 0, t, scr, c.lane);
      convert_misc(a, wsb, 0, c.bid * 512 + c.tid, c.G * 512); convert_misc(a, wsb, 1, c.bid * 512 + c.tid, c.G * 512); }
    mod_items(a, c0, 0);
}

__device__ __forceinline__ void tr_item(const float* W, int ldw, int k0, int n0, bf16* WT, int ldt, int drow0, LAS float* scr, int lane, const float* kscale = nullptr) {
    const float* src = W + (size_t)(k0 + (lane >> 4)) * ldw + n0 + (lane & 15) * 4;
    f32x4 v[16];
#pragma unroll
    for (int i = 0; i < 16; ++i) v[i] = __builtin_nontemporal_load((const f32x4*)(src + (size_t)(4 * i) * ldw));
    LAS float* wp = scr + (lane >> 4) * 65 + (lane & 15) * 4;
#pragma unroll
    for (int i = 0; i < 16; ++i) { LAS float* q = wp + (4 * i) * 65; const float ks = kscale ? kscale[k0 + 4 * i + (lane >> 4)] : 1.f; q[0] = v[i].x * ks; q[1] = v[i].y * ks; q[2] = v[i].z * ks; q[3] = v[i].w * ks; }
    asm volatile("s_waitcnt lgkmcnt(0)" ::: "memory");
    const int kc = lane & 7;
#pragma unroll
    for (int j = 0; j < 8; ++j) { const int n = (lane >> 3) + 8 * j; const LAS float* sp = scr + (8 * kc) * 65 + n;
        u32x4 o; o.x = pk2(sp[0 * 65], sp[1 * 65]); o.y = pk2(sp[2 * 65], sp[3 * 65]); o.z = pk2(sp[4 * 65], sp[5 * 65]); o.w = pk2(sp[6 * 65], sp[7 * 65]);
        __builtin_nontemporal_store(o, (u32x4*)(WT + (size_t)(drow0 + n) * ldt + k0 + 8 * kc)); }
    asm volatile("s_waitcnt lgkmcnt(0)" ::: "memory");
}
__device__ __forceinline__ void tr_item8(const float* W, int ldw, int k0, int n0, unsigned char* WT, int ldt, int drow0, LAS float* scr, int lane) {
    const float* src = W + (size_t)(k0 + (lane >> 4)) * ldw + n0 + (lane & 15) * 4;
    f32x4 v[16];
#pragma unroll
    for (int i = 0; i < 16; ++i) v[i] = __builtin_nontemporal_load((const f32x4*)(src + (size_t)(4 * i) * ldw));
    LAS float* wp = scr + (lane >> 4) * 65 + (lane & 15) * 4;
#pragma unroll
    for (int i = 0; i < 16; ++i) { LAS float* q = wp + (4 * i) * 65; q[0] = v[i].x * W8_SCALE; q[1] = v[i].y * W8_SCALE; q[2] = v[i].z * W8_SCALE; q[3] = v[i].w * W8_SCALE; }
    asm volatile("s_waitcnt lgkmcnt(0)" ::: "memory");
    const int kc = lane & 7;
#pragma unroll
    for (int j = 0; j < 8; ++j) { const int n = (lane >> 3) + 8 * j; const LAS float* sp = scr + (8 * kc) * 65 + n;
        u32x2 o; o.x = pk4_fp8(sp[0 * 65], sp[1 * 65], sp[2 * 65], sp[3 * 65]); o.y = pk4_fp8(sp[4 * 65], sp[5 * 65], sp[6 * 65], sp[7 * 65]);
        __builtin_nontemporal_store(o, (u32x2*)(WT + (size_t)(drow0 + n) * ldt + k0 + 8 * kc)); }
    asm volatile("s_waitcnt lgkmcnt(0)" ::: "memory");
}
__device__ __forceinline__ void norm_mod_row(const float* xrow, const float* g, const float* sh, const float* scl, bf16* orow, int lane) {
    f32x4 v[8], gs[8], sv[8]; float s = 0.f;
#pragma unroll
    for (int j = 0; j < 8; ++j) v[j] = ((const f32x4*)xrow)[lane + 64 * j];
#pragma unroll
    for (int j = 0; j < 8; ++j) { const int idx = (lane + 64 * j) * 4; gs[j] = *(const f32x4*)(g + idx) * (1.f + *(const f32x4*)(scl + idx)); sv[j] = *(const f32x4*)(sh + idx); }
#pragma unroll
    for (int j = 0; j < 8; ++j) s += dot4(v[j], v[j]);
    const float rstd = rsqrtf(wave_sum(s) * (1.f / DM) + EPS);
#pragma unroll
    for (int j = 0; j < 8; ++j) { const int idx = (lane + 64 * j) * 4; const f32x4 o = (v[j] * rstd) * gs[j] + sv[j];
        u32x2 w; w.x = pk2(o.x, o.y); w.y = pk2(o.z, o.w); *(u32x2*)(orow + idx) = w; }
}
__device__ __forceinline__ const float* xin_row(const Args& a, GAS unsigned char* wsb, int l, int row) {
    if (l == 0) return row < NL ? INP(0) + (size_t)row * DM : INP(2) + (size_t)(row - NL) * DM;
    return WSP(const float, WS_X1) + (size_t)row * DM;
}
__device__ __forceinline__ void convert_tile(const Args& a, GAS unsigned char* wsb, int l, int t, LAS float* scr, int lane) {
    constexpr int I_IN = 32 * 45, I_UQ = 8 * 24, I_UKV = 4 * 32, I_OUT = 32 * 32, I_EXP = 32 * 32;
    int r = t;
    if (r < I_IN) { const int kb = r / 45, nb = r - kb * 45; tr_item(INP(7) + (size_t)l * DM * INW, INW, kb * 64, nb * 64, WSW(bf16, W_IN, l), DM, nb * 64, scr, lane); return; }
    r -= I_IN;
    if (r < I_UQ) { const int kb = r / 24, nb = r - kb * 24; tr_item(INP(16) + (size_t)l * QRANK * 1536, 1536, kb * 64, nb * 64, WSW(bf16, W_UQ, l), QRANK, nb * 64, scr, lane, INP(15) + (size_t)l * QRANK); return; }
    r -= I_UQ;
    if (r < I_UKV) { const int kb = r / 32, nb = r - kb * 32; tr_item(INP(18) + (size_t)l * KVRANK * 2048, 2048, kb * 64, nb * 64, WSW(bf16, W_UKV, l), KVRANK, nb * 64, scr, lane, INP(17) + (size_t)l * KVRANK); return; }
    r -= I_UKV;
    if (r < I_OUT) { const int kb = r / 32, nb = r - kb * 32; tr_item(INP(21) + (size_t)l * DM * DM, DM, kb * 64, nb * 64, WSW(bf16, W_OUT, l), DM, nb * 64, scr, lane); return; }
    r -= I_OUT;
    const int which = r / (NE * I_EXP); r -= which * (NE * I_EXP);
    const int e = r / I_EXP; r -= e * I_EXP; const int kb = r / 32, nb = r - kb * 32, n0 = nb * 64;
    const float* W = INP(24 + which) + ((size_t)l * NE + e) * DM * DM;
    if (which == 0)      tr_item8(W, DM, kb * 64, n0, WSW(unsigned char, W_GU, l), DM, e * 4096 + (n0 >> 7) * 256 + (n0 & 127), scr, lane);
    else if (which == 1) tr_item8(W, DM, kb * 64, n0, WSW(unsigned char, W_GU, l), DM, e * 4096 + (n0 >> 7) * 256 + 128 + (n0 & 127), scr, lane);
    else                 tr_item8(W, DM, kb * 64, n0, WSW(unsigned char, W_DN, l), DM, e * 2048 + n0, scr, lane);
}
__device__ __forceinline__ void convert_misc(const Args& a, GAS unsigned char* wsb, int l, int gt, int NGT) {
    { u32x4* z = (u32x4*)(WSW(bf16, W_IN, l) + (size_t)INW * DM); for (int i = gt; i < (INWP - INW) * DM / 8; i += NGT) z[i] = (u32x4){0u, 0u, 0u, 0u}; }
    { bf16* wg = WSW(bf16, W_GT, l);
      for (int i = gt; i < 4096 * 128; i += NGT) { const int ng = i >> 7, kk = i & 127, pn = ng >> 8, n = ng & 255, dir = pn >> 3, gblk = pn & 7, j = n & 127;
          const float* src = (n < 128 ? INP(10) : INP(12)) + ((size_t)((l * 2 + dir) * 8 + gblk)) * 128 * 128;
          wg[i] = (bf16)f2bf(src[kk * 128 + j]); } }
    { float* lsl = WSP(float, WS_LSL) + (size_t)l * 2 * RW; const float* lm = INP(14) + (size_t)l * 2 * RW; for (int i = gt; i < 2 * RW; i += NGT) lsl[i] = -8.f * log1pf(expf(-lm[i])); }
}
__device__ __forceinline__ void bg_fill(const Args& a, const Ctx& c0, int site, int must) {
    PHASE_BEGIN();
    unsigned* ctl = WSP(unsigned, WS_CTL); unsigned* head = ctl + CW_QHEAD; unsigned* done = ctl + CW_QDONE + 64 * site;
    volatile LAS unsigned* bc = (volatile LAS unsigned*)(c.lds + LDS_MISC + 64);
    LAS float* scr = (LAS float*)(c.lds + c.wave * 16640);
    __syncthreads();
    if (c.tid == 0) (void)__hip_atomic_fetch_add(done, 1u, __ATOMIC_RELAXED, __HIP_MEMORY_SCOPE_AGENT);
    for (;;) {
        if (c.tid == 0) { unsigned s = 0xffffffffu;
            const unsigned h = __hip_atomic_load(head, __ATOMIC_RELAXED, __HIP_MEMORY_SCOPE_AGENT);
            bool go = h < (unsigned)must;
            if (!go && h < (unsigned)BG_STEPS) go = __hip_atomic_load(done, __ATOMIC_RELAXED, __HIP_MEMORY_SCOPE_AGENT) + 8u < (unsigned)c.G;
            if (go) { s = __hip_atomic_fetch_add(head, 1u, __ATOMIC_RELAXED, __HIP_MEMORY_SCOPE_AGENT); if (s >= (unsigned)BG_STEPS) s = 0xffffffffu; }
            bc[0] = s; }
        __syncthreads();
        const unsigned s = bc[0];
        if (s == 0xffffffffu) break;
        const int g = (int)s * 8 + c.wave;
        if (g < T_MOE) convert_tile(a, wsb, 0, T_SMALL + g, scr, c.lane); else convert_tile(a, wsb, 1, g - T_MOE, scr, c.lane);
        __syncthreads();
    }
}
__device__ __forceinline__ void bg_take(const Args& a, const Ctx& c0, int n) {
    PHASE_BEGIN();
    unsigned* head = WSP(unsigned, WS_CTL) + CW_QHEAD;
    volatile LAS unsigned* bc = (volatile LAS unsigned*)(c.lds + LDS_MISC + 64);
    LAS float* scr = (LAS float*)(c.lds + c.wave * 16640);
    __syncthreads();
    for (int i = 0; i < n; ++i) {
        if (c.tid == 0) { unsigned s = __hip_atomic_fetch_add(head, 1u, __ATOMIC_RELAXED, __HIP_MEMORY_SCOPE_AGENT); if (s >= (unsigned)BG_STEPS) s = 0xffffffffu; bc[0] = s; }
        __syncthreads();
        const unsigned s = bc[0];
        if (s == 0xffffffffu) break;
        const int g = (int)s * 8 + c.wave;
        if (g < T_MOE) convert_tile(a, wsb, 0, T_SMALL + g, scr, c.lane); else convert_tile(a, wsb, 1, g - T_MOE, scr, c.lane);
        __syncthreads();
    }
    __syncthreads();
}
__device__ __forceinline__ void phase_l0(const Args& a, const Ctx& c0, int l) {
    PHASE_BEGIN();
    const int gw = c.bid * 8 + c.wave, NGW = c.G * 8;
    const float* modv = WSP(const float, WS_MODV);
    for (int row = gw; row < NR; row += NGW) { const int mb = row < NL ? (row >> 12) : 4; const float* mv = modv + (size_t)mb * NMODW;
        norm_mod_row(xin_row(a, wsb, 0, row), INP(6), mv, mv + DM, WSP(bf16, WS_H) + (size_t)row * DM, c.lane); }
}

__device__ __forceinline__ void phase_conv(const Args& a, const Ctx& c0, int l) {
    PHASE_BEGIN();
    const bf16* XR = WSP(const bf16, WS_XR); bf16* U = WSP(bf16, WS_U);
    const float* cw = INP(8) + (size_t)l * 4 * RW; const float* cb = INP(9) + (size_t)l * RW;
    const int ch = (c.tid & 127) * 8, rg = c.tid >> 7;
    float w[4][8], bias[8];
#pragma unroll
    for (int k = 0; k < 4; ++k) { const f32x4 w0 = *(const f32x4*)(cw + k * RW + ch), w1 = *(const f32x4*)(cw + k * RW + ch + 4);
        w[k][0] = w0.x; w[k][1] = w0.y; w[k][2] = w0.z; w[k][3] = w0.w; w[k][4] = w1.x; w[k][5] = w1.y; w[k][6] = w1.z; w[k][7] = w1.w; }
    { const f32x4 b0 = *(const f32x4*)(cb + ch), b1 = *(const f32x4*)(cb + ch + 4); bias[0] = b0.x; bias[1] = b0.y; bias[2] = b0.z; bias[3] = b0.w; bias[4] = b1.x; bias[5] = b1.y; bias[6] = b1.z; bias[7] = b1.w; }
    for (int it = c.bid; it < NB * NCHUNK; it += c.G) {
        const int b = it / NCHUNK, cc = it - b * NCHUNK; const bool isc = cc < 4;
        const int seg0 = isc ? NL + b * CTXL : b * SEQ, T = isc ? CTXL : SEQ, t0 = (isc ? cc : cc - 4) * 64 + rg * 16;
        u32x4 x[19];
#pragma unroll
        for (int i = 0; i < 19; ++i) { const int t = t0 - 2 + i; x[i] = (t >= 0 && t < T) ? *(const u32x4*)(XR + (size_t)(seg0 + t) * RW + ch) : (u32x4){0u, 0u, 0u, 0u}; }
#pragma unroll
        for (int r = 0; r < 16; ++r) { float o[8];
#pragma unroll
            for (int e = 0; e < 8; ++e) o[e] = bias[e];
#pragma unroll
            for (int k = 0; k < 4; ++k) { const u32x4 xv = x[r + k];
                o[0] = fmaf(bflo(xv.x), w[k][0], o[0]); o[1] = fmaf(bfhi(xv.x), w[k][1], o[1]); o[2] = fmaf(bflo(xv.y), w[k][2], o[2]); o[3] = fmaf(bfhi(xv.y), w[k][3], o[3]);
                o[4] = fmaf(bflo(xv.z), w[k][4], o[4]); o[5] = fmaf(bfhi(xv.z), w[k][5], o[5]); o[6] = fmaf(bflo(xv.w), w[k][6], o[6]); o[7] = fmaf(bfhi(xv.w), w[k][7], o[7]); }
            u32x4 wv; wv.x = pk2(o[0], o[1]); wv.y = pk2(o[2], o[3]); wv.z = pk2(o[4], o[5]); wv.w = pk2(o[6], o[7]);
            *(u32x4*)(U + (size_t)(seg0 + t0 + r) * RW + ch) = wv; }
    }
}

__device__ __forceinline__ void phase_prep2(const Args& a, const Ctx& c0, int l, bool last) {
    PHASE_BEGIN();
    const int gw = c.bid * 8 + c.wave, NGW = c.G * 8, lane = c.lane, hh = lane >> 3, s = lane & 7;
    const float* KR = WSP(const float, WS_KR); const float* RSTDK = WSP(const float, WS_RSTDK);
    const float* kn = INP(20) + (size_t)l * DQK; bf16* Ko = WSP(bf16, WS_K);
    const float inv0 = exp2f(-(float)(2 * s) * (13.287712379549449f / 16.f)), inv1 = exp2f(-(float)(2 * s + 1) * (13.287712379549449f / 16.f));
    const f32x2 g1 = *(const f32x2*)(kn + 128 + 2 * s), g2 = *(const f32x2*)(kn + 144 + 2 * s), g3 = *(const f32x2*)(kn + 160 + 2 * s), g4 = *(const f32x2*)(kn + 176 + 2 * s);
    for (int row0 = gw * 2; row0 < NR; row0 += NGW * 2) {
        f32x2 r1[2], r2[2], c1[2], c2[2]; float rk[2];
#pragma unroll
        for (int q = 0; q < 2; ++q) { const float* kr = KR + (size_t)(row0 + q) * 64;
            r1[q] = *(const f32x2*)(kr + 2 * s); r2[q] = *(const f32x2*)(kr + 16 + 2 * s); c1[q] = *(const f32x2*)(kr + 32 + 2 * s); c2[q] = *(const f32x2*)(kr + 48 + 2 * s);
            rk[q] = RSTDK[(size_t)(row0 + q) * 8 + hh]; }
#pragma unroll
        for (int q = 0; q < 2; ++q) { const int row = row0 + q;
            const bool lat = row < NL; const int b = lat ? (row >> 12) : ((row - NL) >> 8); const int t = lat ? (row & (SEQ - 1)) : ((row - NL) & (CTXL - 1));
            const int pos = lat ? CTXL + t : t; const size_t hrow = (size_t)(b * NH + hh) * KVLEN + pos;
            float cr0 = 1.f, sr0 = 0.f, cr1 = 1.f, sr1 = 0.f, cc0 = 1.f, sc0 = 0.f, cc1 = 1.f, sc1 = 0.f;
            if (lat) { const float pr = (float)(t >> 6), pc = (float)(t & 63);
                __sincosf(pr * inv0, &sr0, &cr0); __sincosf(pr * inv1, &sr1, &cr1); __sincosf(pc * inv0, &sc0, &cc0); __sincosf(pc * inv1, &sc1, &cc1); }
            const f32x2 a1 = r1[q] * rk[q] * g1, a2 = r2[q] * rk[q] * g2, b1 = c1[q] * rk[q] * g3, b2 = c2[q] * rk[q] * g4;
            bf16* ko = Ko + hrow * DQK;
            *(unsigned*)(ko + 128 + 2 * s) = pk2(a1.x * cr0 - a2.x * sr0, a1.y * cr1 - a2.y * sr1);
            *(unsigned*)(ko + 144 + 2 * s) = pk2(a2.x * cr0 + a1.x * sr0, a2.y * cr1 + a1.y * sr1);
            *(unsigned*)(ko + 160 + 2 * s) = pk2(b1.x * cc0 - b2.x * sc0, b1.y * cc1 - b2.y * sc1);
            *(unsigned*)(ko + 176 + 2 * s) = pk2(b2.x * cc0 + b1.x * sc0, b2.y * cc1 + b1.y * sc1); }
    }
    const float* AGG = WSP(const float, WS_AGG); float* CAR = WSP(float, WS_CARRY);
    for (int rep = 0; rep < NREP(15); ++rep)
    for (int it = c.bid; it < 16; it += c.G) {
        const int b = it >> 2, dir = (it >> 1) & 1, ch = (it & 1) * 512 + c.tid;
        const float* P = AGG + ((size_t)(dir * 2 + 0) * NB * NCHUNK + b * NCHUNK) * RW + ch; const float* S = AGG + ((size_t)(dir * 2 + 1) * NB * NCHUNK + b * NCHUNK) * RW + ch;
        float* Co = CAR + ((size_t)dir * NB * NCHUNK + b * NCHUNK) * RW + ch;
        float run = 0.f;
        if (dir == 0) {
#pragma unroll 17
            for (int q = 0; q < NCHUNK; ++q) { Co[(size_t)q * RW] = run; run = fmaf(P[(size_t)q * RW], run, S[(size_t)q * RW]); }
        } else {
#pragma unroll
            for (int q = 3; q >= 0; --q) { Co[(size_t)q * RW] = run; run = fmaf(P[(size_t)q * RW], run, S[(size_t)q * RW]); }
#pragma unroll 16
            for (int q = NCHUNK - 1; q >= 4; --q) { Co[(size_t)q * RW] = run; run = fmaf(P[(size_t)q * RW], run, S[(size_t)q * RW]); }
        }
    }
}

__device__ __forceinline__ void phase_attn(const Args& a, const Ctx& c0, int l, bool last) {
    PHASE_BEGIN();
    const bf16* QRAW = WSP(const bf16, WS_QRAW); const float* SSQ = WSP(const float, WS_SSQ); const bf16* K = WSP(const bf16, WS_K); const bf16* V = WSP(const bf16, WS_V); bf16* Y = WSP(bf16, WS_Y);
    const float* qn = INP(19) + (size_t)l * DQK;
    const int nun = last ? 512 : 544;
    for (int rep = 0; rep < NREP(13); ++rep)
    for (int u = c.bid; u < nun; u += c.G) {
        const bool isl = u < 512; const int bh = isl ? (u >> 4) : (u - 512), qb = u & 15, b = bh >> 3, h = bh & 7;
        const int grow0 = isl ? b * SEQ + qb * 256 : NL + b * CTXL;
        int tu = c0.tid; asm volatile("" : "+v"(tu));
        att::attn_unit(QRAW + (size_t)grow0 * 1536 + h * DQK, SSQ + (size_t)grow0 * 16, qn, isl ? qb * 256 : -1, K + (size_t)bh * KVLEN * DQK, V + (size_t)bh * KVLEN * DVH,
                       Y + (size_t)grow0 * DM + RW + h * DVH, isl ? KVLEN : CTXL, (LAS char*)c.lds, tu);
    }
    const char* HP = (const char*)WSP(const char, WS_AB); const float* CAR = WSP(const float, WS_CARRY); const bf16* GR = WSP(const bf16, WS_GR);
    int tid2 = c0.tid; asm volatile("" : "+v"(tid2));
    const int g4 = (tid2 & 255) * 4, rh = tid2 >> 8;
    for (int rep = 0; rep < NREP(14); ++rep)
    for (int it = c.G - 1 - c.bid; it < NB * NCHUNK; it += c.G) {
        const int b = it / NCHUNK, cc = it - b * NCHUNK; if (last && cc < 4) continue;
        const int r0 = (cc < 4 ? NL + b * CTXL + cc * 64 : b * SEQ + (cc - 4) * 64) + rh * 32;
        const f32x4 cf = *(const f32x4*)(CAR + ((size_t)0 * NB * NCHUNK + it) * RW + g4), cb = *(const f32x4*)(CAR + ((size_t)1 * NB * NCHUNK + it) * RW + g4);
        const char* hf = HP + ((size_t)r0 * 1024 + g4) * 4; const char* hb = hf + (size_t)NR * 1024 * 4;
        const bf16* zg = GR + (size_t)r0 * RW + g4; bf16* yo = Y + (size_t)r0 * DM + g4;
#pragma unroll 8
        for (int r = 0; r < 32; ++r) {
            const u32x4 wf = *(const u32x4*)(hf + (size_t)r * 4096), wb = *(const u32x4*)(hb + (size_t)r * 4096); const u32x2 gw2 = *(const u32x2*)(zg + (size_t)r * RW); const f32x4 gr = {bflo(gw2.x), bfhi(gw2.x), bflo(gw2.y), bfhi(gw2.y)};
            const float h0 = fmaf(bflo(wf.z), cf.x, bflo(wf.x)) + fmaf(bflo(wb.z), cb.x, bflo(wb.x)), h1 = fmaf(bfhi(wf.z), cf.y, bfhi(wf.x)) + fmaf(bfhi(wb.z), cb.y, bfhi(wb.x));
            const float h2 = fmaf(bflo(wf.w), cf.z, bflo(wf.y)) + fmaf(bflo(wb.w), cb.z, bflo(wb.y)), h3 = fmaf(bfhi(wf.w), cf.w, bfhi(wf.y)) + fmaf(bfhi(wb.w), cb.w, bfhi(wb.y));
            u32x2 w; w.x = pk2(h0 * gelu_tanh_(gr.x), h1 * gelu_tanh_(gr.y)); w.y = pk2(h2 * gelu_tanh_(gr.z), h3 * gelu_tanh_(gr.w));
            *(u32x2*)(yo + (size_t)r * DM) = w; }
    }
}

__device__ __forceinline__ void phase_router(const Args& a, const Ctx& c0, int l, bool last, int skip) {
    PHASE_BEGIN();
    LAS float* rl = (LAS float*)c.lds;
    const float* rt = INP(23) + (size_t)l * DM * NE;
    for (int i = c.tid; i < DM * NE; i += 512) { const int k = i >> 4, e = i & 15; rl[e * DM + k] = rt[i]; }
    __syncthreads();
    const int gw = (c.bid - skip) * 8 + c.wave, NGW = (c.G - skip) * 8, lane = c.lane, nrows = last ? NL : NR;
    const float* modv = WSP(const float, WS_MODV) + (size_t)l * 5 * NMODW; const float* g = INP(22) + (size_t)l * DM;
    const bf16* XM = WSP(const bf16, WS_XM); float* AFF = WSP(float, WS_AFF);
    const int n1 = skip ? NL / 2 : nrows / 2; int j0 = gw - n1 % NGW; if (j0 < 0) j0 += NGW;
    for (int ph = 0; ph < (skip ? 2 : 1); ++ph) {
    if (ph == 1 && NL / 2 + j0 < NR / 2) {
        unsigned* flag = WSP(unsigned, WS_CTL) + CW_CTXMIX; unsigned sp = 0;
        while (__hip_atomic_load(flag, __ATOMIC_RELAXED, __HIP_MEMORY_SCOPE_AGENT) < (unsigned)skip) { __builtin_amdgcn_s_sleep(2); if (++sp > (1u << 22)) break; }
        __builtin_amdgcn_fence(__ATOMIC_ACQUIRE, "agent"); }
    const int pr0 = ph == 0 ? gw : NL / 2 + j0, prend = ph == 0 ? n1 : NR / 2;
    u32x2 wa[8], wb[8];
    if (pr0 < prend) {
#pragma unroll
        for (int j = 0; j < 8; ++j) { wa[j] = ((const u32x2*)(XM + (size_t)(pr0 * 2) * DM))[lane + 64 * j]; wb[j] = ((const u32x2*)(XM + (size_t)(pr0 * 2 + 1) * DM))[lane + 64 * j]; } }
    for (int pr = pr0; pr < prend; pr += NGW) {
        const int row = pr * 2; const int mb = row < NL ? (row >> 12) : 4; const float* sh = modv + (size_t)mb * NMODW + 3 * DM; const float* scl = sh + DM;
        f32x4 va[8], vb[8]; float sa = 0.f, sb = 0.f;
#pragma unroll
        for (int j = 0; j < 8; ++j) { va[j] = (f32x4){bflo(wa[j].x), bfhi(wa[j].x), bflo(wa[j].y), bfhi(wa[j].y)}; vb[j] = (f32x4){bflo(wb[j].x), bfhi(wb[j].x), bflo(wb[j].y), bfhi(wb[j].y)}; }
        if (pr + NGW < prend) { const int nrow = (pr + NGW) * 2;
#pragma unroll
            for (int j = 0; j < 8; ++j) { wa[j] = ((const u32x2*)(XM + (size_t)nrow * DM))[lane + 64 * j]; wb[j] = ((const u32x2*)(XM + (size_t)(nrow + 1) * DM))[lane + 64 * j]; } }
#pragma unroll
        for (int j = 0; j < 8; ++j) { sa += dot4(va[j], va[j]); sb += dot4(vb[j], vb[j]); }
        const float ra = rsqrtf(wave_sum(sa) * (1.f / DM) + EPS), rb = rsqrtf(wave_sum(sb) * (1.f / DM) + EPS);
        unsigned char* orow = WSP(unsigned char, WS_H) + (size_t)row * DM;
#pragma unroll
        for (int j = 0; j < 8; ++j) { const int idx = (lane + 64 * j) * 4;
            const f32x4 gsv = *(const f32x4*)(g + idx) * (1.f + *(const f32x4*)(scl + idx)), shv = *(const f32x4*)(sh + idx);
            va[j] = (va[j] * ra) * gsv + shv; vb[j] = (vb[j] * rb) * gsv + shv;
            *(unsigned*)(orow + idx) = pk4_fp8(va[j].x, va[j].y, va[j].z, va[j].w); *(unsigned*)(orow + DM + idx) = pk4_fp8(vb[j].x, vb[j].y, vb[j].z, vb[j].w); }
        __builtin_amdgcn_sched_barrier(0);
        float pa[16], pb[16];
        f32x2 ab[8][4];
#pragma unroll
        for (int j = 0; j < 8; ++j) { ab[j][0] = (f32x2){va[j].x, vb[j].x}; ab[j][1] = (f32x2){va[j].y, vb[j].y}; ab[j][2] = (f32x2){va[j].z, vb[j].z}; ab[j][3] = (f32x2){va[j].w, vb[j].w}; }
#pragma unroll
        for (int e = 0; e < 16; ++e) { f32x2 x2 = {0.f, 0.f};
#pragma unroll
            for (int j = 0; j < 8; ++j) { const f32x4 rv = *(const LAS f32x4*)(rl + e * DM + (lane + 64 * j) * 4);
                x2 = __builtin_elementwise_fma(ab[j][0], (f32x2){rv.x, rv.x}, x2); x2 = __builtin_elementwise_fma(ab[j][1], (f32x2){rv.y, rv.y}, x2);
                x2 = __builtin_elementwise_fma(ab[j][2], (f32x2){rv.z, rv.z}, x2); x2 = __builtin_elementwise_fma(ab[j][3], (f32x2){rv.w, rv.w}, x2); }
            pa[e] = x2.x; pb[e] = x2.y; if (e & 1) __builtin_amdgcn_sched_barrier(0); }
#define TR_STEP(N, BIT) _Pragma("unroll") for (int i = 0; i < N; ++i) { const bool up = (lane & BIT) != 0; \
            const float sA = up ? pa[i] : pa[i + N], kA = up ? pa[i + N] : pa[i], sB = up ? pb[i] : pb[i + N], kB = up ? pb[i + N] : pb[i]; \
            pa[i] = kA + __shfl_xor(sA, BIT); pb[i] = kB + __shfl_xor(sB, BIT); }
        TR_STEP(8, 32) TR_STEP(4, 16) TR_STEP(2, 8) TR_STEP(1, 4)
#undef TR_STEP
        float la = pa[0], lb = pb[0];
        la += __shfl_xor(la, 1); lb += __shfl_xor(lb, 1); la += __shfl_xor(la, 2); lb += __shfl_xor(lb, 2);
        float ma = la, mbx = lb;
#pragma unroll
        for (int o = 4; o < 64; o <<= 1) { ma = fmaxf(ma, __shfl_xor(ma, o)); mbx = fmaxf(mbx, __shfl_xor(mbx, o)); }
        const float ea = __expf(la - ma), eb = __expf(lb - mbx); float da = ea, db = eb;
#pragma unroll
        for (int o = 4; o < 64; o <<= 1) { da += __shfl_xor(da, o); db += __shfl_xor(db, o); }
        if ((lane & 3) == 0) { AFF[(size_t)row * NE + (lane >> 2)] = ea / da; AFF[(size_t)(row + 1) * NE + (lane >> 2)] = eb / db; }
    }
    }
}

__device__ __forceinline__ void phase_topk(const Args& a, const Ctx& c0, int l, bool last) {
    PHASE_BEGIN();
    LAS unsigned* hist = (LAS unsigned*)c.lds;
    LAS unsigned* misc = hist + 256;
    LAS unsigned* wtot = misc + 16;
    LAS int* selrow = (LAS int*)(wtot + 16);
    const float* AFF = WSP(const float, WS_AFF); int* SEL = WSP(int, WS_SEL); int* IDXR = WSP(int, WS_IDXR); float* GATEV = WSP(float, WS_GATEV);
    const unsigned char* H = WSP(const unsigned char, WS_H); unsigned char* XG = WSP(unsigned char, WS_XG);
    const int tid = c.tid, lane = c.lane, wave = c.wave;
    const int nit = last ? 256 : 320;
    for (int it = c.bid; it < nit; it += c.G) {
        const int seg = it >= 256 ? 1 : 0, bi = seg ? it - 256 : (it >> 2), qd = seg ? 0 : (it & 3), b = bi >> 4, e = bi & 15;
        const int T = seg ? CTXL : SEQ, cap = seg ? CAP_C : CAP_L, row0 = seg ? NL + b * CTXL : b * SEQ, slot0 = seg ? NB * CAP_L + b * CAP_C : b * CAP_L;
        const int capq = seg ? CAP_C : CAP_L / 4; const unsigned slo = (unsigned)(qd * capq), shi = slo + (unsigned)capq; const int tq = T / (seg ? 1 : 4);
        unsigned k[8];
#pragma unroll
        for (int j = 0; j < 8; ++j) { const int t = tid * 8 + j; k[j] = t < T ? __float_as_uint(AFF[(size_t)(row0 + t) * NE + e]) : 0u; }
        unsigned prefix = 0u, mask = 0u, want = (unsigned)cap;
        for (int pass = 0; pass < 4; ++pass) { const int shift = 24 - 8 * pass;
            if (tid < 256) hist[tid] = 0u;
            __syncthreads();
#pragma unroll
            for (int j = 0; j < 8; ++j) if ((k[j] & mask) == prefix) atomicAdd((unsigned*)&hist[(k[j] >> shift) & 255u], 1u);
            __syncthreads();
            if (tid == 0) { unsigned cum = 0u; int d = 255; for (; d > 0; --d) { const unsigned hh = hist[d]; if (cum + hh >= want) break; cum += hh; } misc[0] = (unsigned)d; misc[1] = want - cum; }
            __syncthreads();
            prefix |= misc[0] << shift; mask |= 255u << shift; want = misc[1];
            __syncthreads();
        }
        const unsigned thr = prefix;
        unsigned cnt = 0u;
#pragma unroll
        for (int j = 0; j < 8; ++j) cnt += (k[j] > thr ? 1u : 0u) + (k[j] == thr ? 0x10000u : 0u);
        unsigned inc = cnt;
#pragma unroll
        for (int o = 1; o < 64; o <<= 1) { const unsigned v = __shfl_up(inc, o); if (lane >= o) inc += v; }
        if (lane == 63) wtot[wave] = inc;
        __syncthreads();
        unsigned base = 0u;
        for (int w = 0; w < wave; ++w) base += wtot[w];
        unsigned run = base + inc - cnt;
        unsigned gt_run = run & 0xffffu, eq_run = run >> 16;
#pragma unroll
        for (int j = 0; j < 8; ++j) { const int t = tid * 8 + j;
            if (t < T) { const bool g = k[j] > thr, q = k[j] == thr; const bool sel = g || (q && eq_run < want);
                const unsigned slot = gt_run + (eq_run < want ? eq_run : want);
                if (sel && slot >= slo && slot < shi) { IDXR[e * EROWS + slot0 + slot] = row0 + t; GATEV[e * EROWS + slot0 + slot] = __uint_as_float(k[j]); selrow[slot - slo] = row0 + t;
                    SEL[(size_t)(row0 + t) * NE + e] = (int)(slot0 + slot); }
                if (!sel && t / tq == qd) SEL[(size_t)(row0 + t) * NE + e] = -1;
                gt_run += g ? 1u : 0u; eq_run += q ? 1u : 0u; } }
        __syncthreads();
        for (int s0 = wave * 8; s0 < capq; s0 += 64) {
            u32x4 t[8][2];
#pragma unroll
            for (int q = 0; q < 8; ++q) { const u32x4* src = (const u32x4*)(H + (size_t)selrow[s0 + q] * DM);
#pragma unroll
                for (int j = 0; j < 2; ++j) t[q][j] = src[lane + 64 * j]; }
#pragma unroll
            for (int q = 0; q < 8; ++q) { u32x4* dst = (u32x4*)(XG + ((size_t)e * EROWS + slot0 + slo + s0 + q) * DM);
#pragma unroll
                for (int j = 0; j < 2; ++j) dst[lane + 64 * j] = t[q][j]; } }
        if (seg == 1 && b == 0) {
            u32x4* dst = (u32x4*)(XG + ((size_t)e * EROWS + 2176) * DM);
            for (int i = tid; i < 128 * DM / 16; i += 512) dst[i] = (u32x4){0u, 0u, 0u, 0u};
            if (tid < 128) GATEV[e * EROWS + 2176 + tid] = 0.f; }
        __syncthreads();
    }
}

__device__ __forceinline__ void phase_combine(const Args& a, const Ctx& c0, int l, bool last_in) {
    PHASE_BEGIN();
    const bool last = last_in;
    const int gw = c.bid * 8 + c.wave, NGW = c.G * 8, lane = c.lane, nrows = last ? NL : NR;
    const bf16* XM = WSP(const bf16, WS_XM); const int* SEL = WSP(const int, WS_SEL); const bf16* YE = WSP(const bf16, WS_YE);
    const float* modv = WSP(const float, WS_MODV) + (size_t)l * 5 * NMODW;
    float* out = a.out; bf16* x1o = WSP(bf16, WS_X1);
    for (int row = gw; row < nrows; row += NGW) {
        const int mb = row < NL ? (row >> 12) : 4; const float* g2 = modv + (size_t)mb * NMODW + 5 * DM;
        const int myslot = lane < 16 ? SEL[(size_t)row * NE + lane] : -1;
        f32x4 xv[4][2], gv[4][2];
#pragma unroll
        for (int j = 0; j < 4; ++j) { const int idx = (lane + 64 * j) * 8; const u32x4 xw = *(const u32x4*)(XM + (size_t)row * DM + idx);
            xv[j][0] = (f32x4){bflo(xw.x), bfhi(xw.x), bflo(xw.y), bfhi(xw.y)}; xv[j][1] = (f32x4){bflo(xw.z), bfhi(xw.z), bflo(xw.w), bfhi(xw.w)};
#pragma unroll
            for (int hlf = 0; hlf < 2; ++hlf) gv[j][hlf] = *(const f32x4*)(g2 + idx + hlf * 4); }
        f32x4 acc[4][2];
#pragma unroll
        for (int j = 0; j < 4; ++j) { acc[j][0] = (f32x4){0.f, 0.f, 0.f, 0.f}; acc[j][1] = (f32x4){0.f, 0.f, 0.f, 0.f}; }
        unsigned long long m = __ballot(myslot >= 0);
        while (m) { const int e = __builtin_ctzll(m); m &= m - 1; const int sl = __shfl(myslot, e);
            const u32x4* y = (const u32x4*)(YE + ((size_t)e * EROWS + sl) * DM);
#pragma unroll
            for (int j = 0; j < 4; ++j) { const u32x4 w = y[lane + 64 * j];
                acc[j][0] += (f32x4){bflo(w.x), bfhi(w.x), bflo(w.y), bfhi(w.y)}; acc[j][1] += (f32x4){bflo(w.z), bfhi(w.z), bflo(w.w), bfhi(w.w)}; } }
        float ssn = 0.f;
#pragma unroll
        for (int j = 0; j < 4; ++j) { const int idx = (lane + 64 * j) * 8;
#pragma unroll
            for (int hlf = 0; hlf < 2; ++hlf) { xv[j][hlf] = xv[j][hlf] + gv[j][hlf] * acc[j][hlf]; ssn += dot4(xv[j][hlf], xv[j][hlf]); }
            if (last) { *(f32x4*)(out + (size_t)row * DM + idx) = xv[j][0]; *(f32x4*)(out + (size_t)row * DM + idx + 4) = xv[j][1]; }
            else { u32x4 w; w.x = pk2(xv[j][0].x, xv[j][0].y); w.y = pk2(xv[j][0].z, xv[j][0].w); w.z = pk2(xv[j][1].x, xv[j][1].y); w.w = pk2(xv[j][1].z, xv[j][1].w); *(u32x4*)(x1o + (size_t)row * DM + idx) = w; } }
        if (!last) {
            const float* mv1 = modv + (size_t)5 * NMODW + (size_t)mb * NMODW; const float* g1n = INP(6) + (size_t)(l + 1) * DM;
            const float rstd = rsqrtf(wave_sum(ssn) * (1.f / DM) + EPS); bf16* hrow = WSP(bf16, WS_H) + (size_t)row * DM;
#pragma unroll
            for (int j = 0; j < 4; ++j) { const int idx = (lane + 64 * j) * 8; u32x4 w;
#pragma unroll
                for (int hlf = 0; hlf < 2; ++hlf) { const int ix = idx + hlf * 4; const f32x4 gsv = *(const f32x4*)(g1n + ix) * (1.f + *(const f32x4*)(mv1 + DM + ix)), shv = *(const f32x4*)(mv1 + ix);
                    const f32x4 o = (xv[j][hlf] * rstd) * gsv + shv;
                    if (hlf == 0) { w.x = pk2(o.x, o.y); w.y = pk2(o.z, o.w); } else { w.z = pk2(o.x, o.y); w.w = pk2(o.z, o.w); } }
                *(u32x4*)(hrow + idx) = w; } }
    }
}

constexpr int PH_PER_LAYER = 12, NPH = 1 + 2 * PH_PER_LAYER;
__global__ void __launch_bounds__(512, 2) mk_fwd(Args a) {
    extern __shared__ __attribute__((aligned(16))) unsigned char lds_raw[];
    Ctx c; c.lds = (LAS unsigned char*)lds_raw; c.tid = threadIdx.x; c.lane = c.tid & 63; c.wave = __builtin_amdgcn_readfirstlane(c.tid >> 6); c.bid = blockIdx.x; c.G = gridDim.x;
    volatile LAS unsigned* MISC = (volatile LAS unsigned*)(c.lds + LDS_MISC);
    if (c.tid < 32) MISC[c.tid] = 0u;
    __syncthreads();
    XcdBarrier bar; bar.bar = (unsigned*)(a.ws + WS_CTL) + 4096; bar.x = 0; bar.st = nullptr;
    const int lo = a.ph_lo, hi = a.ph_hi;
    if (hi - lo > 1) bar = xcd_barrier_post((unsigned*)(a.ws + WS_CTL) + 4096, MISC + 8);
#ifndef PH_MASK
#define PH_MASK 0x1fff
#endif
#define EN(j) ((PH_MASK >> (j)) & 1)

#define IN(k) (lo <= (k) && (k) < hi)
#define SEAM(k) do { if (IN(k) && IN((k) + 1)) { XcdBarrier b_ = bar; { GAS unsigned* t_ = (GAS unsigned*)b_.bar; asm volatile("" : "+s"(t_)); b_.bar = (unsigned*)t_; } xcd_barrier(b_); } } while (0)

    if (EN(12) && IN(0)) for (int rep = 0; rep < NREP(12); ++rep) { phase_mod(a, c); }
    SEAM(0);
    if (hi - lo > 1) {
        if (c.tid == 0) { unsigned* bw = (unsigned*)(a.ws + WS_CTL) + 4096; bool even = (c.G % 8) == 0;
            for (unsigned j = 0; j < 8; ++j) even = even && (xb_ld(&bw[XB_XCNT(j)]) == (unsigned)(c.G / 8));
            MISC[12] = even ? (MISC[10] * 8u + bar.x) : (unsigned)c.bid; }
        __syncthreads();
        c.bid = (int)MISC[12];
    }
    for (int l = 0; l < 2; ++l) {
        const int pb = 1 + l * PH_PER_LAYER; const bool last = (l == 1);
        if (l == 0) {
            if (EN(0) && IN(pb + 0)) for (int rep = 0; rep < NREP(0); ++rep) { phase_l0(a, c, l); }
            SEAM(pb + 0);
        }
        if (EN(1) && IN(pb + 1)) for (int rep = 0; rep < NREP(1); ++rep) {
            GAS unsigned char* wsb = (GAS unsigned char*)a.ws; asm volatile("" : "+s"(wsb));
            ProbIn p; p.K = DM; p.lda = DM; p.ldb = DM; p.ord.init(NR / 256, INWP / 256, c.G, c.bid); p.A = (const char*)WSP(bf16, WS_H); p.Bt = (const char*)WSW(bf16, W_IN, l);
            p.XR = WSP(bf16, WS_XR); p.GR = WSP(bf16, WS_GR); p.CQ = WSP(bf16, WS_CQ); p.CKV = WSP(bf16, WS_CKV); p.KR = WSP(float, WS_KR); p.SSQ = WSP(float, WS_SSQ);
            pg8::gemm_phase(c.lds, p); }
#if BG_FILL_GEMM_TAILS
        if (IN(pb + 1)) bg_fill(a, c, l * 8 + 1, 0);
#endif
        SEAM(pb + 1);
        if (EN(2) && IN(pb + 2)) for (int rep = 0; rep < NREP(2); ++rep) { phase_conv(a, c, l); }
        SEAM(pb + 2);
        if (EN(3) && IN(pb + 3)) for (int rep = 0; rep < NREP(3); ++rep) {
            GAS unsigned char* wsb = (GAS unsigned char*)a.ws; asm volatile("" : "+s"(wsb));
#ifndef NO_QKV
            { ProbQ p; p.K = QRANK; p.lda = QRANK; p.ldb = QRANK; p.ord.init((last ? NL : NR) / 256, 1536 / 256, c.G, c.bid); p.A = (const char*)WSP(bf16, WS_CQ); p.Bt = (const char*)WSW(bf16, W_UQ, l); p.O = WSP(bf16, WS_QRAW);
              pg8::gemm_phase(c.lds, p); }
            { ProbKV p; p.K = KVRANK; p.lda = KVRANK; p.ldb = KVRANK; p.ord.init(NR / 256, NH, c.G, (c.bid + c.G - 216) % c.G); p.A = (const char*)WSP(bf16, WS_CKV);   p.Bt = (const char*)WSW(bf16, W_UKV, l); p.Ko = WSP(bf16, WS_K); p.Vo = WSP(bf16, WS_V);
              p.SSQ = WSP(const float, WS_SSQ); p.RSTDK = WSP(float, WS_RSTDK); p.kn = INP(20) + (size_t)l * DQK; p.part = (LAS float*)(c.lds + 131072);
              pg8::gemm_phase(c.lds, p); }
#endif
#ifndef NO_GATES
            { ProbGates p; p.K = 128; p.lda = RW; p.ldb = 128; p.ord.init(NR / 256, 16, c.G, (c.bid + c.G - 152) % c.G); p.U = (const char*)WSP(bf16, WS_U);   p.Bt = (const char*)WSW(bf16, W_GT, l); p.HP = (char*)WSP(char, WS_AB); p.AGG = WSP(float, WS_AGG);
              p.ba = INP(11) + (size_t)l * 2 * RW; p.bx = INP(13) + (size_t)l * 2 * RW; p.lam = WSP(const float, WS_LSL) + (size_t)l * 2 * RW;
              pg8::gemm_phase(c.lds, p); }
#endif
        }
#if BG_FILL_GEMM_TAILS
        if (IN(pb + 3)) bg_fill(a, c, l * 8 + 2, 0);
#endif
        SEAM(pb + 3);
        if (EN(4) && IN(pb + 4)) for (int rep = 0; rep < NREP(4); ++rep) { phase_prep2(a, c, l, last); }
        SEAM(pb + 4);
        if (IN(pb + 5) && (c.bid & 1) == 0) { if (l == 0) mod_items(a, c, 1); bg_take(a, c, l == 0 ? (c.bid < 32 ? 19 : 27) : 24); }
        if (EN(5) && IN(pb + 5)) for (int rep = 0; rep < NREP(5); ++rep) { phase_attn(a, c, l, last); }
        if (IN(pb + 5) && (c.bid & 1) == 1) { bg_take(a, c, l == 0 ? (c.bid < 32 ? 19 : 27) : 24); if (l == 0) mod_items(a, c, 1); }
#if BG_FILL_GEMM_TAILS
        if (IN(pb + 5) && l == 0) bg_fill(a, c, 3, 0);
#endif
        SEAM(pb + 5);
        if (EN(6) && IN(pb + 6)) for (int rep = 0; rep < NREP(6); ++rep) {
            GAS unsigned char* wsb = (GAS unsigned char*)a.ws; asm volatile("" : "+s"(wsb));
            const bool split = !last && c.G >= 64;
            ProbMixer p; p.K = DM; p.lda = DM; p.ldb = DM; p.ord.init((last || split ? NL : NR) / 256, DM / 256, c.G, c.bid); p.pm0 = 0; p.A = (const char*)WSP(bf16, WS_Y); p.Bt = (const char*)WSW(bf16, W_OUT, l);
            p.xl = l == 0 ? INP(0) : nullptr; p.xc = l == 0 ? INP(2) : nullptr; p.x1 = WSP(const bf16, WS_X1); p.XM = WSP(bf16, WS_XM); p.modv = WSP(const float, WS_MODV) + (size_t)l * 5 * NMODW;
            pg8::gemm_phase(c.lds, p); }
#if BG_FILL_GEMM_TAILS
        if (IN(pb + 6) && l == 0) bg_fill(a, c, 4, 0);
#endif
        SEAM(pb + 6);
        if (EN(7) && IN(pb + 7)) for (int rep = 0; rep < NREP(7); ++rep) {
            const bool split = !last && c.G >= 64;
            if (split && c.bid < 32) {
                GAS unsigned char* wsb = (GAS unsigned char*)a.ws; asm volatile("" : "+s"(wsb));
                ProbMixer p; p.K = DM; p.lda = DM; p.ldb = DM; p.ord.init(NC / 256, DM / 256, 32, c.bid); p.pm0 = NL / 256; p.A = (const char*)WSP(bf16, WS_Y); p.Bt = (const char*)WSW(bf16, W_OUT, l);
                p.xl = l == 0 ? INP(0) : nullptr; p.xc = l == 0 ? INP(2) : nullptr; p.x1 = WSP(const bf16, WS_X1); p.XM = WSP(bf16, WS_XM); p.modv = WSP(const float, WS_MODV) + (size_t)l * 5 * NMODW;
                pg8::gemm_phase(c.lds, p);
                asm volatile("s_waitcnt vmcnt(0)" ::: "memory"); __syncthreads();
                if (threadIdx.x == 0) { __builtin_amdgcn_fence(__ATOMIC_RELEASE, "agent"); __hip_atomic_fetch_add(WSP(unsigned, WS_CTL) + CW_CTXMIX, 1u, __ATOMIC_RELAXED, __HIP_MEMORY_SCOPE_AGENT); }
            } else phase_router(a, c, l, last, split ? 32 : 0); }
        SEAM(pb + 7);
        if (EN(8) && IN(pb + 8)) for (int rep = 0; rep < NREP(8); ++rep) { phase_topk(a, c, l, last); }
        if (IN(pb + 8)) bg_fill(a, c, l * 8 + 5, l == 0 ? BG_E0 : BG_E1);
        SEAM(pb + 8);
        if (EN(9) && IN(pb + 9)) for (int rep = 0; rep < NREP(9); ++rep) {
            GAS unsigned char* wsb = (GAS unsigned char*)a.ws; asm volatile("" : "+s"(wsb));
            ProbGateUp p; p.K = DM; p.lda = DM; p.ldb = DM; p.tpe = last ? 8 : 9; p.ord.init(NE * p.tpe, 16, c.G, c.bid, p.tpe); p.XG = (const char*)WSP(unsigned char, WS_XG); p.Bt = (const char*)WSW(unsigned char, W_GU, l); p.ACT = WSP(unsigned char, WS_ACT);
            pg8::gemm_phase(c.lds, p); }
        SEAM(pb + 9);
        if (EN(10) && IN(pb + 10)) for (int rep = 0; rep < NREP(10); ++rep) {
            GAS unsigned char* wsb = (GAS unsigned char*)a.ws; asm volatile("" : "+s"(wsb));
            ProbDown p; p.K = DM; p.lda = DM; p.ldb = DM; p.tpe = last ? 8 : 9; p.ord.init(NE * p.tpe, 8, c.G, c.bid, p.tpe); p.ACT = (const char*)WSP(unsigned char, WS_ACT); p.Bt = (const char*)WSW(unsigned char, W_DN, l); p.YE = WSP(bf16, WS_YE); p.gatev = WSP(const float, WS_GATEV);
            pg8::gemm_phase(c.lds, p); }
#if BG_FILL_GEMM_TAILS
        if (IN(pb + 10) && l == 0) bg_fill(a, c, 6, 0);
#endif
        SEAM(pb + 10);
        if (EN(11) && IN(pb + 11)) for (int rep = 0; rep < NREP(11); ++rep) { phase_combine(a, c, l, last); }
        if (IN(pb + 11) && l == 0) bg_fill(a, c, 8, BG_E1S);
        SEAM(pb + 11);
    }
#undef IN
#undef SEAM
}

extern "C" void kernel_launch(void* const* d_in, const int* in_sizes, int n_in, void* d_out, int out_size, void* d_ws, size_t ws_size, hipStream_t stream) {
    static int grid = 0;
    if (grid == 0) {
        if (n_in != 27 || out_size != NL * DM || ws_size < WS_END) { fprintf(stderr, "kernel_launch: unexpected shapes (n_in %d out %d ws %zu)\n", n_in, out_size, ws_size); grid = -1; return; }
        int dev = 0, cus = 0, per_cu = 0;
        if (hipGetDevice(&dev) != hipSuccess || hipDeviceGetAttribute(&cus, hipDeviceAttributeMultiprocessorCount, dev) != hipSuccess) { grid = -1; return; }
        if (hipFuncSetAttribute((const void*)mk_fwd, hipFuncAttributeMaxDynamicSharedMemorySize, LDS_BYTES) != hipSuccess) { fprintf(stderr, "kernel_launch: hipFuncSetAttribute failed\n"); grid = -1; return; }
        if (hipOccupancyMaxActiveBlocksPerMultiprocessor(&per_cu, (const void*)mk_fwd, 512, LDS_BYTES) != hipSuccess || per_cu < 1) { fprintf(stderr, "kernel_launch: occupancy query says %d\n", per_cu); }
        (void)hipGetLastError();
        grid = cus;
    }
    if (grid < 0) return;
    (void)hipMemsetAsync((char*)d_ws + WS_CTL, 0, CTL_BYTES, stream);
    Args a{};
    for (int i = 0; i < 27; ++i) a.in[i] = (const float*)d_in[i];
    a.out = (float*)d_out; a.ws = (unsigned char*)d_ws;
#if MK_ONE_LAUNCH
    a.ph_lo = 0; a.ph_hi = NPH;
    hipLaunchKernelGGL(mk_fwd, dim3(grid), dim3(512), LDS_BYTES, stream, a);
#else
    for (int k = 0; k < NPH; ++k) { a.ph_lo = k; a.ph_hi = k + 1; hipLaunchKernelGGL(mk_fwd, dim3(grid), dim3(512), LDS_BYTES, stream, a); }
#endif
    const hipError_t le = hipPeekAtLastError();
    if (le != hipSuccess) fprintf(stderr, "kernel_launch: launch failed: %s\n", hipGetErrorName(le));
}
```

```cpp
#include <hip/hip_runtime.h>
#include <cstdio>
#include <cstdint>

#define LAS __attribute__((address_space(3)))
#define GAS __attribute__((address_space(1)))
typedef unsigned short bf16;
typedef short bf16x8 __attribute__((ext_vector_type(8)));
typedef short s16x4 __attribute__((ext_vector_type(4)));
typedef float f32x4 __attribute__((ext_vector_type(4)));
typedef float f32x2 __attribute__((ext_vector_type(2)));
typedef float f32x16 __attribute__((ext_vector_type(16)));
typedef unsigned u32x4 __attribute__((ext_vector_type(4)));
typedef unsigned u32x2 __attribute__((ext_vector_type(2)));
typedef int v4i __attribute__((ext_vector_type(4)));
typedef int v8i __attribute__((ext_vector_type(8)));

#ifndef BG_FILL_GEMM_TAILS
#define BG_FILL_GEMM_TAILS 0
#endif
#ifndef MK_ONE_LAUNCH
#define MK_ONE_LAUNCH 1
#endif

constexpr int DM = 2048, NB = 4, SEQ = 4096, CTXL = 256;
constexpr int NL = NB * SEQ, NC = NB * CTXL, NR = NL + NC;
constexpr int RW = 1024, NH = 8, DQK = 192, DVH = 128;
constexpr int QRANK = 512, KVRANK = 256, INW = 2880, INWP = 3072;
constexpr int NE = 16, NMODW = 6 * DM;
constexpr int CAP_L = 512, CAP_C = 32, EROWS = 2304;
constexpr int KVLEN = CTXL + SEQ;
constexpr int NCHUNK = 68;
constexpr float EPS = 1e-6f;

constexpr size_t MiB = 1u << 20;
constexpr size_t WS_CTL = 0, CTL_BYTES = 1 * MiB;
constexpr size_t WS_MODV = 1 * MiB, WS_AFF = 2 * MiB, WS_SEL = 4 * MiB, WS_IDXR = 6 * MiB, WS_GATEV = 6 * MiB + 512 * 1024, WS_AGG = 8 * MiB, WS_CARRY = 13 * MiB, WS_LSL = 15 * MiB + 512 * 1024;
constexpr size_t WS_WSET = 16 * MiB, WSET_STRIDE = 410 * MiB;
constexpr size_t W_IN = 0, W_UQ = 12 * MiB, W_UKV = 14 * MiB, W_GT = 15 * MiB, W_OUT = 18 * MiB, W_GU = 26 * MiB, W_DN = 282 * MiB;
constexpr size_t WS_H = 836 * MiB, WS_U = 904 * MiB, WS_AB = 938 * MiB;
constexpr size_t WS_K = 1074 * MiB, WS_V = 1125 * MiB, WS_Y = 1159 * MiB, WS_XM = 1227 * MiB, WS_X1 = 1363 * MiB;
constexpr size_t WS_OV = 1499 * MiB;
constexpr size_t WS_XR = WS_OV, WS_GR = WS_OV + 34 * MiB, WS_CQ = WS_OV + 68 * MiB, WS_CKV = WS_OV + 85 * MiB, WS_KR = WS_OV + 94 * MiB, WS_QRAW = WS_OV + 99 * MiB, WS_SSQ = WS_OV + 150 * MiB, WS_RSTDK = WS_OV + 152 * MiB;
constexpr size_t WS_XG = WS_OV, WS_ACT = WS_OV + 144 * MiB, WS_YE = WS_OV + 288 * MiB, WS_END = WS_OV + 432 * MiB;
static_assert(WS_YE + (size_t)NE * EROWS * DM * 2 <= WS_END && WS_END <= 2048 * MiB, "workspace map");
constexpr int CW_QHEAD = 8192, CW_QDONE = 8256;
constexpr int T_SMALL = 32 * 45 + 8 * 24 + 4 * 32 + 32 * 32, T_MOE = 3 * NE * 32 * 32, T_LAYER = T_SMALL + T_MOE;
constexpr int BG_TILES = T_MOE + T_LAYER, BG_STEPS = BG_TILES / 8;
constexpr int BG_E0 = T_MOE / 8, BG_E1S = (T_MOE + T_SMALL) / 8, BG_E1 = BG_STEPS;
static_assert(T_MOE % 8 == 0 && T_SMALL % 8 == 0, "step granularity");

constexpr int CW_CTXMIX = 12000;
constexpr int LDS_BYTES = 163840;
constexpr int LDS_MISC = LDS_BYTES - 4096;

struct Args { const float* in[27]; float* out; unsigned char* ws; int ph_lo, ph_hi; };

__device__ __forceinline__ unsigned f2bf(float f) { unsigned u = __builtin_bit_cast(unsigned, f); return (u + 0x7fffu + ((u >> 16) & 1u)) >> 16; }
__device__ __forceinline__ unsigned pk2(float lo, float hi) { return f2bf(lo) | (f2bf(hi) << 16); }
__device__ __forceinline__ float bf2f(unsigned short b) { return __builtin_bit_cast(float, (unsigned)b << 16); }
__device__ __forceinline__ float bflo(unsigned w) { return __builtin_bit_cast(float, w << 16); }
__device__ __forceinline__ float bfhi(unsigned w) { return __builtin_bit_cast(float, w & 0xffff0000u); }
__device__ __forceinline__ float wave_sum(float v) {
#pragma unroll
    for (int o = 1; o < 64; o <<= 1) v += __shfl_xor(v, o);
    return v;
}
__device__ __forceinline__ float sigmoid_(float x) { return 1.f / (1.f + __expf(-x)); }
__device__ __forceinline__ float silu_(float x) { return x * sigmoid_(x); }
__device__ __forceinline__ float sigmoid_fast(float x) { return __builtin_amdgcn_rcpf(1.f + __expf(-x)); }
__device__ __forceinline__ float silu_fast(float x) { return x * sigmoid_fast(x); }
__device__ __forceinline__ float one_minus_exp(float x) { const float p = -x * (1.f + x * (0.5f + x * (0.16666667f + x * (0.041666668f + x * 0.0083333338f)))); return x > -0.1f ? p : 1.f - __expf(x); }
__device__ __forceinline__ float gelu_tanh_(float x) { const float u = 0.7978845608028654f * (x + 0.044715f * x * x * x); const float t = 1.f - 2.f / (1.f + __expf(2.f * u)); return 0.5f * x * (1.f + t); }
__device__ __forceinline__ float sat8(float x) { return __builtin_amdgcn_fmed3f(x, -448.f, 448.f); }
__device__ __forceinline__ unsigned pk4_fp8(float a, float b, float c, float d) { int w = __builtin_amdgcn_cvt_pk_fp8_f32(sat8(a), sat8(b), 0, false); w = __builtin_amdgcn_cvt_pk_fp8_f32(sat8(c), sat8(d), w, true); return (unsigned)w; }
constexpr float W8_SCALE = 64.f;
__device__ __forceinline__ float dot4(f32x4 a, f32x4 b) { return (a.x * b.x + a.y * b.y) + (a.z * b.z + a.w * b.w); }

#define XB_TMO      128
#define XB_XCNT(j)  (256  + 64 * (j))
#define XB_XSUB(j)  (1280 + 64 * (j))
#define XB_XGEN(j)  (2304 + 64 * (j))
#define XB_TOP      3328
#define XB_TOPGEN   3392
#define XCD_BAR_WORDS 3456
#define XB_SPIN_CAP (1u << 18)
__device__ __forceinline__ unsigned xb_ld(unsigned* p)              { return __hip_atomic_load(p, __ATOMIC_RELAXED, __HIP_MEMORY_SCOPE_AGENT); }
__device__ __forceinline__ unsigned xb_add(unsigned* p, unsigned v) { return __hip_atomic_fetch_add(p, v, __ATOMIC_RELAXED, __HIP_MEMORY_SCOPE_AGENT); }
__device__ __forceinline__ unsigned xb_xcc_id() { return (unsigned)__builtin_amdgcn_s_getreg((3 << 11) | 20) & 0xFu; }
#define XB_SPIN(cond, bar) do { unsigned _sp = 0; while (cond) { __builtin_amdgcn_s_sleep(1); \
    if ((++_sp & 255u) == 0u) { if (xb_ld(&(bar)[XB_TMO])) break; if (_sp > XB_SPIN_CAP) { atomicAdd(&(bar)[XB_TMO], 1u); break; } } } } while (0)
struct XcdBarrier { unsigned* bar; unsigned x; volatile LAS unsigned* st; };
__device__ __forceinline__ XcdBarrier xcd_barrier_post(unsigned* bar, volatile LAS unsigned* st) {
    XcdBarrier b; b.bar = bar; b.x = xb_xcc_id(); b.st = st;
    if (threadIdx.x == 0) st[2] = xb_add(&bar[XB_XCNT(b.x)], 1u);
    return b;
}
__device__ __forceinline__ void xcd_barrier_complete(unsigned* bar, unsigned x, unsigned& nloc, unsigned& nx) {
    const unsigned G = gridDim.x * gridDim.y * gridDim.z;
    unsigned sum, cnt, mine, sp = 0u;
    for (;;) {
        sum = 0u; cnt = 0u; mine = 0u;
#pragma unroll
        for (unsigned j = 0; j < 16; ++j) { const unsigned c = xb_ld(&bar[XB_XCNT(j)]); sum += c; cnt += (c > 0u) ? 1u : 0u; mine = (j == x) ? c : mine; }
        if (sum == G) break;
        __builtin_amdgcn_s_sleep(1);
        if ((++sp & 255u) == 0u) { if (xb_ld(&bar[XB_TMO])) break; if (sp > XB_SPIN_CAP) { atomicAdd(&bar[XB_TMO], 1u); break; } }
    }
    nloc = mine > 0u ? mine : 1u; nx = cnt > 0u ? cnt : 1u;
}
__device__ __forceinline__ void xcd_barrier(const XcdBarrier& b) {
    asm volatile("s_waitcnt vmcnt(0)" ::: "memory");
    __syncthreads();
    if (threadIdx.x == 0) {
        unsigned* bar = b.bar;
        __builtin_amdgcn_s_waitcnt(0);
        unsigned nloc = b.st[0], nx = b.st[1];
        if (nloc == 0u) { xcd_barrier_complete(bar, b.x, nloc, nx); b.st[0] = nloc; b.st[1] = nx; }
        const unsigned old = xb_add(&bar[XB_XSUB(b.x)], 1u);
        const unsigned gen = old / nloc;
        if (old + 1u == (gen + 1u) * nloc) {
            __builtin_amdgcn_fence(__ATOMIC_RELEASE, "agent");
            asm volatile("s_waitcnt vmcnt(0)" ::: "memory");
            const unsigned og = xb_add(&bar[XB_TOP], 1u);
            const unsigned tg = og / nx;
            if (og + 1u == (tg + 1u) * nx) xb_add(&bar[XB_TOPGEN], 1u);
            else XB_SPIN(xb_ld(&bar[XB_TOPGEN]) == tg, bar);
            __builtin_amdgcn_fence(__ATOMIC_ACQUIRE, "agent");
            xb_add(&bar[XB_XGEN(b.x)], 1u);
            asm volatile("s_waitcnt vmcnt(0)" ::: "memory");
        } else {
            XB_SPIN(xb_ld(&bar[XB_XGEN(b.x)]) == gen, bar);
            __builtin_amdgcn_fence(__ATOMIC_ACQUIRE, "agent");
            asm volatile("s_waitcnt vmcnt(0)" ::: "memory");
        }
    }
    __syncthreads();
}

namespace pg8 {
constexpr int BM = 256, BK = 64, HALF = 128, HTB = HALF * BK * 2, STAGE_BYTES = 8 * HTB, NXCD = 8, WGM = 8;
__device__ __forceinline__ int lds_byte(int r, int c) { const int st = (r >> 4) * 2 + (c >> 5), rr = r & 15, cc = c & 31, ob = rr * 64 + cc * 2; return st * 1024 + (ob ^ (((ob >> 9) & 1) << 5)); }
__device__ __forceinline__ void stage_rc(int b, int& R, int& C) { const int st = b / 1024, sb = b % 1024, swz = sb ^ (((sb >> 9) & 1) << 5); R = (st >> 1) * 16 + swz / 64; C = (st & 1) * 32 + (swz % 64) / 2; }
__device__ __forceinline__ int perm32(int rho) { const int n = rho >> 4, i = rho & 15; return 8 * (i >> 2) + 4 * n + (i & 3); }
struct Unit { int pm, pn; };
struct TileOrder {
    int nM, nN, nwg, G, c, wgm;
    __device__ __forceinline__ void init(int nM_, int nN_, int G_, int c_, int wgm_ = WGM) { nM = nM_; nN = nN_; nwg = nM * nN; G = G_; c = c_; wgm = wgm_; }
    __device__ __forceinline__ bool next(int i, Unit& u) const {
        const long L = (long)i * G + c; if (L >= nwg) return false;
        int wgid = (int)L; { const int q = nwg / NXCD, r = nwg % NXCD, xcd = wgid % NXCD, off = wgid / NXCD; wgid = (xcd < r ? xcd * (q + 1) : r * (q + 1) + (xcd - r) * q) + off; }
        const int nig = wgm * nN, gid = wgid / nig, fm = gid * wgm, gsz = (nM - fm) < wgm ? (nM - fm) : wgm;
        u.pm = fm + ((wgid % nig) % gsz); u.pn = (wgid % nig) / gsz; return true;
    }
};
template <class P>
__device__ __forceinline__ void gemm_phase(LAS unsigned char* lds, const P& p) {
    int tid_ = threadIdx.x; asm volatile("" : "+v"(tid_));
    const int tid = tid_, wid = __builtin_amdgcn_readfirstlane(tid >> 6), lane = tid & 63, wr = wid >> 2, wc = wid & 3, fr = lane & 15, fq = lane >> 4;
    constexpr int EB = P::EB;
    int nt_ = p.K * EB / 128; asm volatile("" : "+s"(nt_)); const int nt = nt_;
    unsigned voffA[2], voffB[2];
#pragma unroll
    for (int i = 0; i < 2; ++i) { int R, C; stage_rc(tid * 16 + i * 8192, R, C); const int Rb = P::PERM ? ((R & ~31) + perm32(R & 31)) : R;
        voffA[i] = (unsigned)(R * p.lda * EB + C * 2); voffB[i] = (unsigned)(Rb * p.ldb * EB + C * 2); }
    const size_t kstep = 128;
    const size_t hstepA = (size_t)HALF * p.lda * EB, hstepB = (size_t)HALF * p.ldb * EB;
    const unsigned ldsw = (unsigned)wid * 1024u;
    const int aoff = EB == 2 ? lds_byte(wr * 64 + fr, fq * 8) : lds_byte(wr * 64 + fr, (fq & 1) * 16) + (fq >> 1) * 1024;
    const int boff = EB == 2 ? lds_byte(wc * 32 + fr, fq * 8) : lds_byte(wc * 32 + fr, (fq & 1) * 16) + (fq >> 1) * 1024;
    constexpr int KOFF = EB == 2 ? 1024 : 16;
    const int sc1 = 0x7f7f7f7f;
#define PG8_SA(b, h) (((b) * 2 + (h)) * HTB)
#define PG8_SB(b, h) ((4 + (b) * 2 + (h)) * HTB)
#define PG8_STAGE(bufoff, gbase, voff) do { _Pragma("unroll") for (int _i = 0; _i < 2; ++_i) \
        __builtin_amdgcn_global_load_lds((const unsigned*)((const char*)(gbase) + (voff)[_i]), (LAS unsigned*)(lds + (bufoff) + ldsw + _i * 8192), 16, 0, 0); } while (0)
#define PG8_LDA(dst, b, h) do { _Pragma("unroll") for (int m = 0; m < 4; ++m) _Pragma("unroll") for (int k = 0; k < 2; ++k) dst[m][k] = *(const LAS v4i*)(lds + PG8_SA(b, h) + aoff + m * 2048 + k * KOFF); } while (0)
#define PG8_LDB(dst, b, h) do { _Pragma("unroll") for (int n = 0; n < 2; ++n) _Pragma("unroll") for (int k = 0; k < 2; ++k) dst[n][k] = *(const LAS v4i*)(lds + PG8_SB(b, h) + boff + n * 2048 + k * KOFF); } while (0)
#define PG8_MMA(ai, bj, At, Bt) do { __builtin_amdgcn_s_setprio(1); _Pragma("unroll") for (int m = 0; m < 4; ++m) _Pragma("unroll") for (int n = 0; n < 2; ++n) { \
        if constexpr (EB == 2) { _Pragma("unroll") for (int k = 0; k < 2; ++k) acc[ai][bj][m][n] = __builtin_amdgcn_mfma_f32_16x16x32_bf16(__builtin_bit_cast(bf16x8, Bt[n][k]), __builtin_bit_cast(bf16x8, At[m][k]), acc[ai][bj][m][n], 0, 0, 0); } \
        else { const v8i bq_ = __builtin_shufflevector(Bt[n][0], Bt[n][1], 0, 1, 2, 3, 4, 5, 6, 7), aq_ = __builtin_shufflevector(At[m][0], At[m][1], 0, 1, 2, 3, 4, 5, 6, 7); \
            asm volatile("v_mfma_scale_f32_16x16x128_f8f6f4 %0, %1, %2, %0, %3, %3 op_sel_hi:[0,0,0]" : "+v"(acc[ai][bj][m][n]) : "v"(bq_), "v"(aq_), "v"(sc1)); } } \
        __builtin_amdgcn_s_setprio(0); } while (0)
#define PG8_WAIT_V(n) asm volatile("s_waitcnt vmcnt(" #n ")" ::: "memory")
#define PG8_WAIT_L(n) asm volatile("s_waitcnt lgkmcnt(" #n ")" ::: "memory")
#define PG8_BAR __builtin_amdgcn_s_barrier()
#define PG8_SCHED __builtin_amdgcn_sched_barrier(0)
    Unit cur, nxt; int ui = 0;
    if (!p.ord.next(0, cur)) return;
    f32x4 acc[2][2][4][2];
#pragma unroll
    for (int a = 0; a < 2; ++a)
#pragma unroll
        for (int b = 0; b < 2; ++b)
#pragma unroll
            for (int m = 0; m < 4; ++m)
#pragma unroll
                for (int n = 0; n < 2; ++n) acc[a][b][m][n] = (f32x4){0.f, 0.f, 0.f, 0.f};
    v4i At[4][2], B0[2][2], B1[2][2];
    const char* cA = p.a_base(cur); const char* cB = p.b_base(cur);
    PG8_STAGE(PG8_SB(0, 0), cB, voffB); PG8_STAGE(PG8_SB(0, 1), cB + hstepB, voffB); PG8_STAGE(PG8_SA(0, 0), cA, voffA); PG8_STAGE(PG8_SA(0, 1), cA + hstepA, voffA);
    if (wr == 1) PG8_BAR;
    PG8_WAIT_V(2); PG8_BAR;
    PG8_STAGE(PG8_SB(1, 0), cB + kstep, voffB); PG8_STAGE(PG8_SA(1, 0), cA + kstep, voffA); PG8_STAGE(PG8_SB(1, 1), cB + hstepB + kstep, voffB);
    PG8_WAIT_V(6); PG8_BAR;
    for (;;) {
        const bool has_next = p.ord.next(ui + 1, nxt);
        const char* nA = has_next ? p.a_base(nxt) : cA; const char* nB = has_next ? p.b_base(nxt) : cB;
        for (int t = 0; t < nt; t += 2) {
            const bool last = (t == nt - 2);
            const char* a1 = cA + (size_t)(t + 1) * kstep;
            const char* a2 = last ? nA : cA + (size_t)(t + 2) * kstep; const char* b2 = last ? nB : cB + (size_t)(t + 2) * kstep;
            const char* a3 = a2 + kstep; const char* b3 = b2 + kstep;
            PG8_LDB(B0, 0, 0); PG8_LDB(B1, 0, 1); PG8_SCHED; PG8_LDA(At, 0, 0); PG8_STAGE(PG8_SA(1, 1), a1 + hstepA, voffA);
            PG8_WAIT_V(8); PG8_WAIT_L(0); PG8_BAR; PG8_MMA(0, 0, At, B0); PG8_MMA(0, 1, At, B1); PG8_BAR; PG8_SCHED;
            PG8_LDA(At, 0, 1); PG8_STAGE(PG8_SB(0, 0), b2, voffB); PG8_STAGE(PG8_SB(0, 1), b2 + hstepB, voffB); PG8_STAGE(PG8_SA(0, 0), a2, voffA);
            PG8_WAIT_V(8); PG8_WAIT_L(0); PG8_BAR; PG8_MMA(1, 0, At, B0); PG8_MMA(1, 1, At, B1); PG8_BAR; PG8_SCHED;
            PG8_LDB(B0, 1, 0); PG8_LDB(B1, 1, 1); PG8_SCHED; PG8_LDA(At, 1, 0); PG8_STAGE(PG8_SA(0, 1), a2 + hstepA, voffA);
            PG8_WAIT_V(8); PG8_WAIT_L(0); PG8_BAR; PG8_MMA(0, 0, At, B0); PG8_MMA(0, 1, At, B1); PG8_BAR; PG8_SCHED;
            PG8_LDA(At, 1, 1); PG8_STAGE(PG8_SB(1, 0), b3, voffB); PG8_STAGE(PG8_SB(1, 1), b3 + hstepB, voffB); PG8_STAGE(PG8_SA(1, 0), a3, voffA);
            PG8_WAIT_V(8); PG8_WAIT_L(0); PG8_BAR; PG8_MMA(1, 0, At, B0); PG8_MMA(1, 1, At, B1); PG8_BAR; PG8_SCHED;
        }
        if (wr == 0) PG8_BAR;
        p.epi(acc, cur, wr, wc, fr, fq);
        if (!has_next) break;
#pragma unroll
        for (int a = 0; a < 2; ++a)
#pragma unroll
            for (int b = 0; b < 2; ++b)
#pragma unroll
                for (int m = 0; m < 4; ++m)
#pragma unroll
                    for (int n = 0; n < 2; ++n) acc[a][b][m][n] = (f32x4){0.f, 0.f, 0.f, 0.f};
        cur = nxt; cA = nA; cB = nB; ++ui;
        if (wr == 1) PG8_BAR;
    }
    PG8_WAIT_V(0);
    PG8_BAR;
#undef PG8_SA
#undef PG8_SB
#undef PG8_STAGE
#undef PG8_LDA
#undef PG8_LDB
#undef PG8_MMA
#undef PG8_WAIT_V
#undef PG8_WAIT_L
#undef PG8_BAR
#undef PG8_SCHED
}
}
using pg8::Unit;

struct ProbIn {
    static constexpr bool PERM = true; static constexpr int EB = 2;
    int K, lda, ldb; pg8::TileOrder ord; const char* A; const char* Bt; bf16* XR; bf16* GR; bf16* CQ; bf16* CKV; float* KR; float* SSQ;
    __device__ __forceinline__ const char* a_base(const Unit& u) const { return A + (size_t)u.pm * 256 * lda * 2; }
    __device__ __forceinline__ const char* b_base(const Unit& u) const { return Bt + (size_t)u.pn * 256 * ldb * 2; }
    __device__ __forceinline__ void epi(const f32x4 (&acc)[2][2][4][2], const Unit& u, int wr, int wc, int fr, int fq) const {
        const int pn = u.pn; const size_t rowt = (size_t)u.pm * 256;
        unsigned lrow = (unsigned)(wr * 64 + fr), lcol = (unsigned)(wc * 32 + 8 * fq); asm volatile("" : "+v"(lrow), "+v"(lcol));
        if (pn < 11) {
            bf16* dst; int ld;
            if (pn < 4) { dst = XR + rowt * 1024 + pn * 256; ld = 1024; } else if (pn < 8) { dst = GR + rowt * 1024 + (pn - 4) * 256; ld = 1024; }
            else if (pn < 10) { dst = CQ + rowt * 512 + (pn - 8) * 256; ld = 512; } else { dst = CKV + rowt * 256; ld = 256; }
            const unsigned loff = (lrow * (unsigned)ld + lcol) * 2u;
#pragma unroll
            for (int ai = 0; ai < 2; ++ai)
#pragma unroll
                for (int m = 0; m < 4; ++m) {
#pragma unroll
                    for (int bj = 0; bj < 2; ++bj) { const f32x4 v0 = acc[ai][bj][m][0], v1 = acc[ai][bj][m][1];
                        u32x4 w; w.x = pk2(v0[0], v0[1]); w.y = pk2(v0[2], v0[3]); w.z = pk2(v1[0], v1[1]); w.w = pk2(v1[2], v1[3]);
                        *(u32x4*)((char*)dst + ((size_t)(ai * 128 + m * 16) * ld + bj * 128) * 2 + loff) = w; } }
            if (pn >= 8) {
                float* sq = SSQ + rowt * 16 + (pn < 10 ? (pn - 8) * 4 : 8) + wc;
#pragma unroll
                for (int ai = 0; ai < 2; ++ai)
#pragma unroll
                    for (int m = 0; m < 4; ++m) { float ss = 0.f;
#pragma unroll
                        for (int bj = 0; bj < 2; ++bj)
#pragma unroll
                            for (int n = 0; n < 2; ++n) ss += dot4(acc[ai][bj][m][n], acc[ai][bj][m][n]);
                        ss += __shfl_xor(ss, 16); ss += __shfl_xor(ss, 32);
                        if (fq == 0) *(float*)((char*)sq + ((size_t)(ai * 128 + m * 16) * 16 + lrow * 16u) * 4) = ss; } }
        } else if (wc < 2) {
            float* kd = KR + rowt * 64; float* sq = SSQ + rowt * 16 + 12 + wc;
#pragma unroll
            for (int ai = 0; ai < 2; ++ai)
#pragma unroll
                for (int m = 0; m < 4; ++m) { const size_t ro = (size_t)(ai * 128 + m * 16);
                    *(f32x4*)((char*)kd + (ro * 64 + lrow * 64u + lcol) * 4) = acc[ai][0][m][0]; *(f32x4*)((char*)kd + (ro * 64 + lrow * 64u + lcol + 4) * 4) = acc[ai][0][m][1];
                    float ss = dot4(acc[ai][0][m][0], acc[ai][0][m][0]) + dot4(acc[ai][0][m][1], acc[ai][0][m][1]);
                    ss += __shfl_xor(ss, 16); ss += __shfl_xor(ss, 32);
                    if (fq == 0) *(float*)((char*)sq + (ro * 16 + lrow * 16u) * 4) = ss; }
        }
    }
};
struct ProbQ {
    static constexpr bool PERM = true; static constexpr int EB = 2;
    int K, lda, ldb; pg8::TileOrder ord; const char* A; const char* Bt; bf16* O;
    __device__ __forceinline__ const char* a_base(const Unit& u) const { return A + (size_t)u.pm * 256 * lda * 2; }
    __device__ __forceinline__ const char* b_base(const Unit& u) const { return Bt + (size_t)u.pn * 256 * ldb * 2; }
    __device__ __forceinline__ void epi(const f32x4 (&acc)[2][2][4][2], const Unit& u, int wr, int wc, int fr, int fq) const {
        unsigned loff = (unsigned)((wr * 64 + fr) * 1536 + wc * 32 + 8 * fq) * 2u; asm volatile("" : "+v"(loff));
        char* base = (char*)(O + (size_t)u.pm * 256 * 1536 + (size_t)u.pn * 256);
#pragma unroll
        for (int ai = 0; ai < 2; ++ai)
#pragma unroll
            for (int m = 0; m < 4; ++m)
#pragma unroll
                for (int bj = 0; bj < 2; ++bj) { const f32x4 v0 = acc[ai][bj][m][0], v1 = acc[ai][bj][m][1];
                    u32x4 w; w.x = pk2(v0[0], v0[1]); w.y = pk2(v0[2], v0[3]); w.z = pk2(v1[0], v1[1]); w.w = pk2(v1[2], v1[3]);
                    *(u32x4*)(base + ((size_t)(ai * 128 + m * 16) * 1536 + bj * 128) * 2 + loff) = w; }
    }
};
struct ProbKV {
    static constexpr bool PERM = true; static constexpr int EB = 2;
    int K, lda, ldb; pg8::TileOrder ord; const char* A; const char* Bt; bf16* Ko; bf16* Vo; const float* SSQ; float* RSTDK; const float* kn; LAS float* part;
    __device__ __forceinline__ const char* a_base(const Unit& u) const { return A + (size_t)u.pm * 256 * lda * 2; }
    __device__ __forceinline__ const char* b_base(const Unit& u) const { return Bt + (size_t)u.pn * 256 * ldb * 2; }
    __device__ __forceinline__ void epi(const f32x4 (&acc)[2][2][4][2], const Unit& u, int wr, int wc, int fr, int fq) const {
        const int h = u.pn; const int rowt = u.pm * 256; const bool lat = rowt < NL;
        const int b = lat ? (rowt >> 12) : ((rowt - NL) >> 8); const int pos0 = lat ? CTXL + (rowt & (SEQ - 1)) : ((rowt - NL) & (CTXL - 1));
        const size_t hrow0 = (size_t)(b * NH + h) * KVLEN + pos0;
        unsigned lrow = (unsigned)(wr * 64 + fr), lcol = (unsigned)(wc * 32 + 8 * fq); asm volatile("" : "+v"(lrow), "+v"(lcol));
        const char* sq = (const char*)(SSQ + (size_t)rowt * 16);
        float sc[2][4], kr2[2][4];
#pragma unroll
        for (int ai = 0; ai < 2; ++ai)
#pragma unroll
            for (int m = 0; m < 4; ++m) { const char* q = sq + ((size_t)(ai * 128 + m * 16) * 16 + lrow * 16u) * 4;
                const f32x4 pk = *(const f32x4*)(q + 32); const f32x2 pr = *(const f32x2*)(q + 48);
                sc[ai][m] = rsqrtf(((pk.x + pk.y) + (pk.z + pk.w)) * (1.f / KVRANK) + EPS); kr2[ai][m] = pr.x + pr.y;
                float ss = 0.f;
#pragma unroll
                for (int n = 0; n < 2; ++n) { const f32x4 y = acc[ai][0][m][n] * sc[ai][m]; ss += dot4(y, y); }
                ss += __shfl_xor(ss, 16); ss += __shfl_xor(ss, 32);
                if (fq == 0) part[(ai * 128 + m * 16 + lrow) * 4 + wc] = ss; }
        asm volatile("s_waitcnt lgkmcnt(0)" ::: "memory"); __builtin_amdgcn_s_barrier(); asm volatile("" ::: "memory");
        const f32x4 g0 = *(const f32x4*)((const char*)kn + lcol * 4), g1 = *(const f32x4*)((const char*)kn + lcol * 4 + 16);
        const unsigned frp = ((unsigned)fr & 3u) | (((unsigned)fr & 8u) >> 1) | (((unsigned)fr & 4u) << 1);
        unsigned voff = (unsigned)wr * 16384u + (4u * (frp >> 3) + (unsigned)wc) * 512u + (frp & 7u) * 64u + (unsigned)fq * 16u; asm volatile("" : "+v"(voff));
        const unsigned koff = (lrow * (unsigned)DQK + lcol) * 2u;
        char* kb = (char*)(Ko + hrow0 * DQK); char* vb = (char*)(Vo + hrow0 * DVH);
#pragma unroll
        for (int ai = 0; ai < 2; ++ai)
#pragma unroll
            for (int m = 0; m < 4; ++m) { const f32x4 pt = *(const LAS f32x4*)(part + (ai * 128 + m * 16 + lrow) * 4);
                const float tot = ((pt.x + pt.y) + (pt.z + pt.w)) + kr2[ai][m]; const float rk = rsqrtf(tot * (1.f / DQK) + EPS); const float f = sc[ai][m] * rk;
                const f32x4 k0 = acc[ai][0][m][0] * f * g0, k1 = acc[ai][0][m][1] * f * g1, v0 = acc[ai][1][m][0] * sc[ai][m], v1 = acc[ai][1][m][1] * sc[ai][m];
                u32x4 w; w.x = pk2(k0[0], k0[1]); w.y = pk2(k0[2], k0[3]); w.z = pk2(k1[0], k1[1]); w.w = pk2(k1[2], k1[3]);
                *(u32x4*)(kb + (size_t)(ai * 128 + m * 16) * DQK * 2 + koff) = w;
                w.x = pk2(v0[0], v0[1]); w.y = pk2(v0[2], v0[3]); w.z = pk2(v1[0], v1[1]); w.w = pk2(v1[2], v1[3]);
                *(u32x4*)(vb + (size_t)(ai * 2) * 16384 + m * 4096 + voff) = w;
                if (wc == 0 && fq == 0) RSTDK[(size_t)(rowt + ai * 128 + m * 16 + lrow) * 8 + h] = rk; }
    }
};
template <int CTRL> __device__ __forceinline__ float dppf(float old, float src) {
    return __builtin_bit_cast(float, __builtin_amdgcn_update_dpp(__builtin_bit_cast(int, old), __builtin_bit_cast(int, src), CTRL, 0xF, 0xF, false));
}
struct ProbGates {
    static constexpr bool PERM = false; static constexpr int EB = 2;
    int K, lda, ldb; pg8::TileOrder ord; const char* U; const char* Bt; char* HP; float* AGG; const float* ba; const float* bx; const float* lam;
    __device__ __forceinline__ const char* a_base(const Unit& u) const { return U + ((size_t)u.pm * 256 * 1024 + (size_t)(u.pn & 7) * 128) * 2; }
    __device__ __forceinline__ const char* b_base(const Unit& u) const { return Bt + (size_t)u.pn * 256 * 128 * 2; }
    template <bool BWD>
    __device__ __forceinline__ void epi_dir(const f32x4 (&acc)[2][2][4][2], const Unit& u, int wr, int wc, int fr, int fq) const {
        const int dir = BWD ? 1 : 0, gblk = u.pn & 7;
        unsigned coff = (unsigned)(wc * 32 + 4 * fq) * 4u;
        unsigned loffu = (unsigned)((wr * 64 + fr) * 1024 + wc * 32 + 4 * fq) * 2u;
        asm volatile("" : "+v"(coff), "+v"(loffu));
        const unsigned loffh = loffu * 2u;
        const size_t ubase = ((size_t)u.pm * 256 * 1024 + (size_t)gblk * 128);
        const char* Ub = U + ubase * 2;
        char* Hb = HP + ((size_t)dir * NR * 1024 + ubase) * 4;
        const char* bap = (const char*)(ba + dir * 1024 + gblk * 128); const char* bxp = (const char*)(bx + dir * 1024 + gblk * 128); const char* lmp = (const char*)(lam + dir * 1024 + gblk * 128);
        const int rowt = u.pm * 256; const int lane = fq * 16 + fr;
        const int bsel = (lane & 48) | (BWD ? 0 : 15);
#pragma unroll
        for (int ai = 0; ai < 2; ++ai) {
            const int r64 = rowt + ai * 128 + wr * 64; const int chunk = r64 < NL ? (r64 >> 12) * NCHUNK + 4 + ((r64 & (SEQ - 1)) >> 6) : ((r64 - NL) >> 8) * NCHUNK + (((r64 - NL) & (CTXL - 1)) >> 6);
#pragma unroll
            for (int n = 0; n < 2; ++n) {
                f32x4 A[4], H[4];
                const f32x4 bav = *(const f32x4*)(bap + n * 64 + coff), bxv = *(const f32x4*)(bxp + n * 64 + coff), lsl = *(const f32x4*)(lmp + n * 64 + coff);
#pragma unroll
                for (int m = 0; m < 4; ++m) {
                    const u32x2 uw = *(const u32x2*)(Ub + ((size_t)(ai * 128 + m * 16) * 1024 + n * 16) * 2 + loffu);
                    const float uv[4] = {bflo(uw.x), bfhi(uw.x), bflo(uw.y), bfhi(uw.y)};
#pragma unroll
                    for (int j = 0; j < 4; ++j) { const float r = sigmoid_fast(acc[ai][0][m][n][j] + bav[j]), ig = sigmoid_fast(acc[ai][1][m][n][j] + bxv[j]);
                        const float la = r * lsl[j]; A[m][j] = __expf(la); H[m][j] = __builtin_amdgcn_sqrtf(one_minus_exp(2.f * la)) * (ig * uv[j]); } }
#pragma unroll
                for (int m = 0; m < 4; ++m)
#pragma unroll
                    for (int j = 0; j < 4; ++j) { float av = A[m][j], hv = H[m][j];
#define SCAN_STEP(D) { const float ap = dppf<(BWD ? 0x100 : 0x110) + D>(1.f, av), hp = dppf<(BWD ? 0x100 : 0x110) + D>(0.f, hv); hv = fmaf(av, hp, hv); av = av * ap; }
                        SCAN_STEP(1) SCAN_STEP(2) SCAN_STEP(4) SCAN_STEP(8)
#undef SCAN_STEP
                        A[m][j] = av; H[m][j] = hv; }
#pragma unroll
                for (int j = 0; j < 4; ++j) { float Ar = 1.f, Hr = 0.f;
#pragma unroll
                    for (int mm = 0; mm < 4; ++mm) { const int m = BWD ? 3 - mm : mm;
                        H[m][j] = fmaf(A[m][j], Hr, H[m][j]); A[m][j] = A[m][j] * Ar;
                        if (mm < 3) { Ar = __shfl(A[m][j], bsel); Hr = __shfl(H[m][j], bsel); } } }
#pragma unroll
                for (int m = 0; m < 4; ++m) { u32x4 w; w.x = pk2(H[m][0], H[m][1]); w.y = pk2(H[m][2], H[m][3]); w.z = pk2(A[m][0], A[m][1]); w.w = pk2(A[m][2], A[m][3]);
                    *(u32x4*)(Hb + ((size_t)(ai * 128 + m * 16) * 1024 + n * 16) * 4 + loffh) = w; }
                constexpr int me = BWD ? 0 : 3;
                if (fr == (BWD ? 0 : 15)) { const size_t o = (size_t)chunk * 1024 + gblk * 128 + n * 16;
                    *(f32x4*)((char*)(AGG + (size_t)(dir * 2 + 0) * NB * NCHUNK * 1024 + o) + coff) = A[me];
                    *(f32x4*)((char*)(AGG + (size_t)(dir * 2 + 1) * NB * NCHUNK * 1024 + o) + coff) = H[me]; }
                asm volatile("" ::: "memory"); __builtin_amdgcn_sched_barrier(0);
            }
        }
    }
    __device__ __forceinline__ void epi(const f32x4 (&acc)[2][2][4][2], const Unit& u, int wr, int wc, int fr, int fq) const {
        if ((u.pn >> 3) == 0) epi_dir<false>(acc, u, wr, wc, fr, fq); else epi_dir<true>(acc, u, wr, wc, fr, fq);
    }
};
struct ProbMixer {
    static constexpr bool PERM = true; static constexpr int EB = 2;
    int K, lda, ldb; pg8::TileOrder ord; const char* A; const char* Bt; const float* xl; const float* xc; const bf16* x1; bf16* XM; const float* modv; int pm0;
    __device__ __forceinline__ const char* a_base(const Unit& u) const { return A + (size_t)(u.pm + pm0) * 256 * 2048 * 2; }
    __device__ __forceinline__ const char* b_base(const Unit& u) const { return Bt + (size_t)u.pn * 256 * 2048 * 2; }
    __device__ __forceinline__ void epi(const f32x4 (&acc)[2][2][4][2], const Unit& u, int wr, int wc, int fr, int fq) const {
        const int rowt = (u.pm + pm0) * 256; const int mb = rowt < NL ? (rowt >> 12) : 4;
        const bool f32in = xl != nullptr;
        const char* xin = f32in ? (const char*)(rowt < NL ? xl + (size_t)rowt * DM : xc + (size_t)(rowt - NL) * DM) + (size_t)u.pn * 1024 : (const char*)(x1 + (size_t)rowt * DM) + (size_t)u.pn * 512;
        const char* g1 = (const char*)(modv + mb * NMODW + 2 * DM) + (size_t)u.pn * 1024;
        char* xo = (char*)(XM + (size_t)rowt * DM) + (size_t)u.pn * 512;
        unsigned lcol = (unsigned)(wc * 32 + 8 * fq), lrow = (unsigned)(wr * 64 + fr); asm volatile("" : "+v"(lcol), "+v"(lrow));
        const unsigned loff4 = (lrow * DM + lcol) * 4u, loff2 = (lrow * DM + lcol) * 2u;
#pragma unroll
        for (int ai = 0; ai < 2; ++ai)
#pragma unroll
            for (int m = 0; m < 4; ++m) { const size_t ro = (size_t)(ai * 128 + m * 16) * DM;
#pragma unroll
                for (int bj = 0; bj < 2; ++bj) { const int cofs = bj * 128;
                    const f32x4 g0 = *(const f32x4*)(g1 + cofs * 4 + lcol * 4), g1v = *(const f32x4*)(g1 + cofs * 4 + lcol * 4 + 16);
                    f32x4 x0, x1v;
                    if (f32in) { x0 = *(const f32x4*)(xin + (ro + cofs) * 4 + loff4); x1v = *(const f32x4*)(xin + (ro + cofs) * 4 + loff4 + 16); }
                    else { const u32x4 w = *(const u32x4*)(xin + (ro + cofs) * 2 + loff2); x0 = (f32x4){bflo(w.x), bfhi(w.x), bflo(w.y), bfhi(w.y)}; x1v = (f32x4){bflo(w.z), bfhi(w.z), bflo(w.w), bfhi(w.w)}; }
                    const f32x4 o0 = x0 + g0 * acc[ai][bj][m][0], o1 = x1v + g1v * acc[ai][bj][m][1];
                    u32x4 ow; ow.x = pk2(o0[0], o0[1]); ow.y = pk2(o0[2], o0[3]); ow.z = pk2(o1[0], o1[1]); ow.w = pk2(o1[2], o1[3]);
                    *(u32x4*)(xo + (ro + cofs) * 2 + loff2) = ow; }
                asm volatile("" ::: "memory"); }
    }
};
struct ProbGateUp {
    static constexpr bool PERM = true; static constexpr int EB = 1;
    int K, lda, ldb; pg8::TileOrder ord; const char* XG; const char* Bt; unsigned char* ACT; int tpe;
    __device__ __forceinline__ const char* a_base(const Unit& u) const { const int e = u.pm / tpe, t = u.pm - e * tpe; return XG + ((size_t)e * EROWS + (size_t)t * 256) * 2048; }
    __device__ __forceinline__ const char* b_base(const Unit& u) const { const int e = u.pm / tpe; return Bt + ((size_t)e * 4096 + (size_t)u.pn * 256) * 2048; }
    __device__ __forceinline__ void epi(const f32x4 (&acc)[2][2][4][2], const Unit& u, int wr, int wc, int fr, int fq) const {
        const int e = u.pm / tpe, t = u.pm - e * tpe;
        char* base = (char*)(ACT + ((size_t)e * EROWS + (size_t)t * 256) * 2048 + (size_t)u.pn * 128);
        unsigned loff = (unsigned)((wr * 64 + fr) * 2048 + wc * 32 + 8 * fq); asm volatile("" : "+v"(loff));
        constexpr float S = 1.f / W8_SCALE;
#pragma unroll
        for (int ai = 0; ai < 2; ++ai)
#pragma unroll
            for (int m = 0; m < 4; ++m) {
                float o[8];
#pragma unroll
                for (int n = 0; n < 2; ++n)
#pragma unroll
                    for (int j = 0; j < 4; ++j) o[n * 4 + j] = silu_fast(acc[ai][0][m][n][j] * S) * (acc[ai][1][m][n][j] * S);
                u32x2 w; w.x = pk4_fp8(o[0], o[1], o[2], o[3]); w.y = pk4_fp8(o[4], o[5], o[6], o[7]);
                *(u32x2*)(base + (size_t)(ai * 128 + m * 16) * 2048 + loff) = w; }
    }
};
struct ProbDown {
    static constexpr bool PERM = true; static constexpr int EB = 1;
    int K, lda, ldb; pg8::TileOrder ord; const char* ACT; const char* Bt; bf16* YE; const float* gatev; int tpe;
    __device__ __forceinline__ const char* a_base(const Unit& u) const { const int e = u.pm / tpe, t = u.pm - e * tpe; return ACT + ((size_t)e * EROWS + (size_t)t * 256) * 2048; }
    __device__ __forceinline__ const char* b_base(const Unit& u) const { const int e = u.pm / tpe; return Bt + ((size_t)e * 2048 + (size_t)u.pn * 256) * 2048; }
    __device__ __forceinline__ void epi(const f32x4 (&acc)[2][2][4][2], const Unit& u, int wr, int wc, int fr, int fq) const {
        const int e = u.pm / tpe, t = u.pm - e * tpe; const size_t rowt = (size_t)e * EROWS + (size_t)t * 256;
        char* base = (char*)(YE + rowt * 2048 + (size_t)u.pn * 256); const char* gp = (const char*)(gatev + rowt);
        unsigned loff = (unsigned)((wr * 64 + fr) * 2048 + wc * 32 + 8 * fq) * 2u, goff = (unsigned)(wr * 64 + fr) * 4u; asm volatile("" : "+v"(loff), "+v"(goff));
#pragma unroll
        for (int ai = 0; ai < 2; ++ai)
#pragma unroll
            for (int m = 0; m < 4; ++m) { const float g = *(const float*)(gp + (ai * 128 + m * 16) * 4 + goff) * (1.f / W8_SCALE);
#pragma unroll
                for (int bj = 0; bj < 2; ++bj) { const f32x4 v0 = acc[ai][bj][m][0] * g, v1 = acc[ai][bj][m][1] * g;
                    u32x4 w; w.x = pk2(v0[0], v0[1]); w.y = pk2(v0[2], v0[3]); w.z = pk2(v1[0], v1[1]); w.w = pk2(v1[2], v1[3]);
                    *(u32x4*)(base + ((size_t)(ai * 128 + m * 16) * 2048 + bj * 128) * 2 + loff) = w; } }
    }
};

namespace att {
constexpr int NW = 8, QBLK = 32, KVBLK = 64;
constexpr float SCALE = 0.07216878364870322f;
constexpr float THR = 8.f;
constexpr int KROWB = 400;
constexpr int SHM_V = KVBLK * DVH * 2, SHM_K = KVBLK * KROWB;
constexpr int NQR = 12;
constexpr int QROWB = (12 - NQR) * 32 + 16;
constexpr int LDS_V = 0, LDS_K = 2 * SHM_V, LDS_WS = 2 * SHM_V + 2 * SHM_K, LDS_QR = LDS_WS + NW * 64 * 4, LDS_TOTAL = LDS_QR + 256 * QROWB;
static_assert(LDS_TOTAL <= LDS_MISC, "attention LDS");
#define SBAR() __builtin_amdgcn_sched_barrier(0)
__device__ __forceinline__ int crow(int r, int hi) { return (r & 3) + 8 * (r >> 2) + 4 * hi; }
__device__ __forceinline__ unsigned cvtpk(float lo, float hi) { unsigned r; asm volatile("v_cvt_pk_bf16_f32 %0, %1, %2" : "=v"(r) : "v"(lo), "v"(hi)); return r; }
constexpr float QSC = SCALE * 1.4426950408889634f;
constexpr float THRL = THR * 1.4426950408889634f;
__device__ __forceinline__ void partialSM(f32x16& p0, f32x16& p1, f32x16& negm, float& l_reg, f32x16* o, LAS float* al_l, int r32, int hi) {
    float ma = fmaxf(fmaxf(p0[0], p0[1]), p0[2]), mb = fmaxf(fmaxf(p1[0], p1[1]), p1[2]);
#pragma unroll
    for (int r = 3; r + 1 < 16; r += 2) { ma = fmaxf(fmaxf(ma, p0[r]), p0[r + 1]); mb = fmaxf(fmaxf(mb, p1[r]), p1[r + 1]); }
    float pmax = fmaxf(fmaxf(ma, mb), fmaxf(p0[15], p1[15]));
    { auto rr = __builtin_amdgcn_permlane32_swap(__float_as_uint(pmax), __float_as_uint(pmax), false, false);
      pmax = fmaxf(__uint_as_float(rr[0]), __uint_as_float(rr[1])); }
    if (__builtin_expect(!__all(pmax <= THRL), 0)) {
        const float d = fmaxf(pmax, 0.f), alpha = __builtin_amdgcn_exp2f(-d), nm = negm[0] - d;
        l_reg *= alpha;
#pragma unroll
        for (int r = 0; r < 16; ++r) { p0[r] -= d; p1[r] -= d; negm[r] = nm; }
        if (hi == 0) al_l[r32] = alpha;
        asm volatile("s_waitcnt lgkmcnt(0)" ::: "memory");
#pragma unroll
        for (int dd = 0; dd < 4; ++dd)
#pragma unroll
            for (int r = 0; r < 16; ++r) o[dd][r] *= al_l[crow(r, hi)];
    }
#pragma unroll
    for (int r = 0; r < 16; ++r) p0[r] = __builtin_amdgcn_exp2f(p0[r]);
}
__device__ __forceinline__ void partialSM_first(f32x16& p0, f32x16& p1, f32x16& negm) {
    float pmax = p0[0];
#pragma unroll
    for (int r = 1; r < 16; ++r) pmax = fmaxf(pmax, p0[r]);
#pragma unroll
    for (int r = 0; r < 16; ++r) pmax = fmaxf(pmax, p1[r]);
    { auto rr = __builtin_amdgcn_permlane32_swap(__float_as_uint(pmax), __float_as_uint(pmax), false, false);
      pmax = fmaxf(__uint_as_float(rr[0]), __uint_as_float(rr[1])); }
#pragma unroll
    for (int r = 0; r < 16; ++r) { p0[r] -= pmax; p1[r] -= pmax; negm[r] = -pmax; }
#pragma unroll
    for (int r = 0; r < 16; ++r) p0[r] = __builtin_amdgcn_exp2f(p0[r]);
}
__device__ __forceinline__ void finishSM(f32x16& p0, f32x16& p1, float& l_reg, bf16x8& pa0, bf16x8& pa1, bf16x8& pa2, bf16x8& pa3) {
#pragma unroll
    for (int r = 0; r < 16; ++r) p1[r] = __builtin_amdgcn_exp2f(p1[r]);
    float ps = 0;
#pragma unroll
    for (int r = 0; r < 16; ++r) ps += p0[r];
#pragma unroll
    for (int r = 0; r < 16; ++r) ps += p1[r];
    { auto rr = __builtin_amdgcn_permlane32_swap(__float_as_uint(ps), __float_as_uint(ps), false, false);
      ps = __uint_as_float(rr[0]) + __uint_as_float(rr[1]); }
    l_reg += ps;
#define PK4(P, BASE, OUT) do { unsigned a0 = cvtpk(P[BASE + 0], P[BASE + 1]), a1 = cvtpk(P[BASE + 2], P[BASE + 3]);   \
    unsigned b0 = cvtpk(P[BASE + 4], P[BASE + 5]), b1 = cvtpk(P[BASE + 6], P[BASE + 7]);                              \
    auto r0 = __builtin_amdgcn_permlane32_swap(a0, b0, false, false); auto r1 = __builtin_amdgcn_permlane32_swap(a1, b1, false, false); \
    u32x4 w = {r0[0], r1[0], r0[1], r1[1]}; OUT = *reinterpret_cast<bf16x8*>(&w); } while (0)
    PK4(p0, 0, pa0); PK4(p0, 8, pa1); PK4(p1, 0, pa2); PK4(p1, 8, pa3);
#undef PK4
}
__device__ __forceinline__ void qkt(f32x16& p0, f32x16& p1, const LAS char* Kl, const bf16x8* qr, const LAS char* Ql, const f32x16& init) {
#pragma unroll
    for (int d0 = 0; d0 < 12; ++d0) {
        const bf16x8 b0 = *reinterpret_cast<const LAS bf16x8*>(Kl + d0 * 32);
        const bf16x8 b1 = *reinterpret_cast<const LAS bf16x8*>(Kl + 32 * KROWB + d0 * 32);
        const bf16x8 q = d0 < NQR ? qr[d0 < NQR ? d0 : 0] : *reinterpret_cast<const LAS bf16x8*>(Ql + (d0 - NQR) * 32);
        p0 = __builtin_amdgcn_mfma_f32_32x32x16_bf16(b0, q, d0 == 0 ? init : p0, 0, 0, 0);
        p1 = __builtin_amdgcn_mfma_f32_32x32x16_bf16(b1, q, d0 == 0 ? init : p1, 0, 0, 0); }
}
__device__ __forceinline__ int v_st(int k, int c) { const int kk = (k & ~0xC) | ((k & 4) << 1) | ((k & 8) >> 1); return ((kk >> 3) * 4 + (c >> 5)) * 512 + ((kk & 7) * 32 + (c & 31)) * 2; }
__device__ __forceinline__ int v_rd_base(int lane) { return ((lane & 3) << 3) | (((lane >> 2) & 3) << 6) | (((lane >> 4) & 1) << 5) | (((lane >> 5) & 1) << 8); }
constexpr int v_rd_off(int d0, int ks, int half) { return d0 * 512 + ks * 4096 + half * 2048; }
template <int OFF> __device__ __forceinline__ s16x4 tr_read(int vb) {
    s16x4 r; asm volatile("ds_read_b64_tr_b16 %0, %1 offset:%2" : "=&v"(r) : "v"(vb), "i"(OFF) : "memory"); return r;
}
template <int D0> __device__ __forceinline__ void pv_one(f32x16& od, int vb, bf16x8 pa0, bf16x8 pa1, bf16x8 pa2, bf16x8 pa3) {
    const s16x4 l0 = tr_read<v_rd_off(D0, 0, 0)>(vb), h0 = tr_read<v_rd_off(D0, 0, 1)>(vb), l1 = tr_read<v_rd_off(D0, 1, 0)>(vb), h1 = tr_read<v_rd_off(D0, 1, 1)>(vb);
    const s16x4 l2 = tr_read<v_rd_off(D0, 2, 0)>(vb), h2 = tr_read<v_rd_off(D0, 2, 1)>(vb), l3 = tr_read<v_rd_off(D0, 3, 0)>(vb), h3 = tr_read<v_rd_off(D0, 3, 1)>(vb);
    asm volatile("s_waitcnt lgkmcnt(0)" ::: "memory"); SBAR();
#define PK(L, H) (bf16x8){L[0], L[1], L[2], L[3], H[0], H[1], H[2], H[3]}
    od = __builtin_amdgcn_mfma_f32_32x32x16_bf16(pa0, PK(l0, h0), od, 0, 0, 0);
    od = __builtin_amdgcn_mfma_f32_32x32x16_bf16(pa1, PK(l1, h1), od, 0, 0, 0);
    od = __builtin_amdgcn_mfma_f32_32x32x16_bf16(pa2, PK(l2, h2), od, 0, 0, 0);
    od = __builtin_amdgcn_mfma_f32_32x32x16_bf16(pa3, PK(l3, h3), od, 0, 0, 0);
#undef PK
}
__device__ __forceinline__ void pv_d0(f32x16* o, int vb, bf16x8 pa0, bf16x8 pa1, bf16x8 pa2, bf16x8 pa3) {
    pv_one<0>(o[0], vb, pa0, pa1, pa2, pa3); pv_one<1>(o[1], vb, pa0, pa1, pa2, pa3); pv_one<2>(o[2], vb, pa0, pa1, pa2, pa3); pv_one<3>(o[3], vb, pa0, pa1, pa2, pa3);
}
__device__ __forceinline__ void attn_unit(const bf16* __restrict__ Qraw, const float* __restrict__ ssq, const float* __restrict__ qn, int t0, const bf16* __restrict__ Kh, const bf16* __restrict__ Vh, bf16* __restrict__ Ob, int seq, LAS char* lds, int tid) {
    const int wid = __builtin_amdgcn_readfirstlane(tid >> 6), lane = tid & 63, r32 = lane & 31, hi = lane >> 5;
    LAS char* V_lds = lds + LDS_V; LAS char* K_lds = lds + LDS_K;
    LAS float* ws = (LAS float*)(lds + LDS_WS) + wid * 64; LAS float* li_l = ws; LAS float* al_l = ws + 32;
    float l_reg = 0; f32x16 o[4] = {}; bf16x8 qr[NQR];
    const char* Qw = (const char*)Qraw + (size_t)(wid * QBLK) * 1536 * 2; const unsigned qoff = (unsigned)(r32 * 1536 + hi * 8) * 2u;
    LAS char* Ql = lds + LDS_QR + (wid * QBLK + r32) * QROWB + hi * 16;
    {
        bf16x8 raw[12];
        unsigned gq = (unsigned)hi * 32u; asm volatile("" : "+v"(gq));
        const char* qnb = (const char*)qn;
#pragma unroll
        for (int d0 = 0; d0 < 12; ++d0) raw[d0] = *reinterpret_cast<const bf16x8*>(Qw + d0 * 32 + qoff);
        const float* sp = ssq + (size_t)(wid * QBLK + r32) * 16; const f32x4 p0 = *(const f32x4*)sp, p1 = *(const f32x4*)(sp + 4);
        const float sq = rsqrtf((((p0.x + p0.y) + (p0.z + p0.w)) + ((p1.x + p1.y) + (p1.z + p1.w))) * (1.f / QRANK) + EPS);
        float ss = 0.f;
#pragma unroll
        for (int d0 = 0; d0 < 12; ++d0)
#pragma unroll
            for (int e = 0; e < 8; ++e) { const float y = bf2f((unsigned short)raw[d0][e]) * sq; ss = fmaf(y, y, ss); }
        ss += __shfl_xor(ss, 32);
        const float f = sq * rsqrtf(ss * (1.f / DQK) + EPS) * QSC;
#pragma unroll
        for (int d0 = 0; d0 < 8; ++d0) { const f32x4 g0 = *(const f32x4*)(qnb + d0 * 64 + gq), g1 = *(const f32x4*)(qnb + d0 * 64 + 16 + gq);
            u32x4 w; w.x = pk2(bf2f((unsigned short)raw[d0][0]) * f * g0.x, bf2f((unsigned short)raw[d0][1]) * f * g0.y); w.y = pk2(bf2f((unsigned short)raw[d0][2]) * f * g0.z, bf2f((unsigned short)raw[d0][3]) * f * g0.w);
            w.z = pk2(bf2f((unsigned short)raw[d0][4]) * f * g1.x, bf2f((unsigned short)raw[d0][5]) * f * g1.y); w.w = pk2(bf2f((unsigned short)raw[d0][6]) * f * g1.z, bf2f((unsigned short)raw[d0][7]) * f * g1.w);
            if (d0 < NQR) qr[d0 < NQR ? d0 : 0] = __builtin_bit_cast(bf16x8, w); else *reinterpret_cast<LAS bf16x8*>(Ql + (d0 - NQR) * 32) = __builtin_bit_cast(bf16x8, w); }
        const int t = t0 + wid * QBLK + r32; const float pr = (float)(t >> 6), pc = (float)(t & 63);
#pragma unroll
        for (int ax = 0; ax < 2; ++ax) {
            float x1[8], x2[8];
            const f32x4 ga0 = *(const f32x4*)(qnb + (128 + 32 * ax) * 4 + gq), ga1 = *(const f32x4*)(qnb + (128 + 32 * ax) * 4 + 16 + gq), gb0 = *(const f32x4*)(qnb + (144 + 32 * ax) * 4 + gq), gb1 = *(const f32x4*)(qnb + (144 + 32 * ax) * 4 + 16 + gq);
            const float ga[8] = {ga0.x, ga0.y, ga0.z, ga0.w, ga1.x, ga1.y, ga1.z, ga1.w}, gb[8] = {gb0.x, gb0.y, gb0.z, gb0.w, gb1.x, gb1.y, gb1.z, gb1.w};
#pragma unroll
            for (int e = 0; e < 8; ++e) { x1[e] = bf2f((unsigned short)raw[8 + 2 * ax][e]) * f * ga[e]; x2[e] = bf2f((unsigned short)raw[9 + 2 * ax][e]) * f * gb[e]; }
            if (t0 >= 0) { const float p = ax ? pc : pr;
#pragma unroll
                for (int e = 0; e < 8; ++e) { const float inv = __builtin_amdgcn_exp2f(-(float)((gq >> 2) + e) * (13.287712379549449f / 16.f)); float sn, cs; __sincosf(p * inv, &sn, &cs);
                    const float y1 = x1[e] * cs - x2[e] * sn, y2 = x2[e] * cs + x1[e] * sn; x1[e] = y1; x2[e] = y2; } }
            u32x4 w; w.x = pk2(x1[0], x1[1]); w.y = pk2(x1[2], x1[3]); w.z = pk2(x1[4], x1[5]); w.w = pk2(x1[6], x1[7]);
            if (8 + 2 * ax < NQR) qr[8 + 2 * ax < NQR ? 8 + 2 * ax : 0] = __builtin_bit_cast(bf16x8, w); else *reinterpret_cast<LAS bf16x8*>(Ql + (8 + 2 * ax >= NQR ? 8 - NQR + 2 * ax : 0) * 32) = __builtin_bit_cast(bf16x8, w);
            w.x = pk2(x2[0], x2[1]); w.y = pk2(x2[2], x2[3]); w.z = pk2(x2[4], x2[5]); w.w = pk2(x2[6], x2[7]);
            if (9 + 2 * ax < NQR) qr[9 + 2 * ax < NQR ? 9 + 2 * ax : 0] = __builtin_bit_cast(bf16x8, w); else *reinterpret_cast<LAS bf16x8*>(Ql + (9 + 2 * ax >= NQR ? 9 - NQR + 2 * ax : 0) * 32) = __builtin_bit_cast(bf16x8, w); }
    }
#define KOFS(j_) ({ const int p_ = 64 * (wid + 8 * (j_)) + lane, row_ = p_ / 25; int cc_ = p_ - row_ * 25; if (cc_ == 24) cc_ = 0; (unsigned)((row_ < 64 ? row_ : 0) * (DQK * 2) + cc_ * 16); })
    const unsigned ko0 = KOFS(0), ko1 = KOFS(1), ko2 = KOFS(2), ko3 = KOFS(3);
#undef KOFS
    const unsigned vo0 = (unsigned)(wid * 1024 + lane * 16);
    const int vb0 = (int)(unsigned)(size_t)V_lds + v_rd_base(lane);
    const LAS char* Kl0 = K_lds + r32 * KROWB + hi * 16;
#define DMA_V(k0, b) do { const char* vb_ = (const char*)Vh + (size_t)(k0) * (DVH * 2); LAS char* ld_ = V_lds + (b) * SHM_V + wid * 1024; \
    unsigned a0_ = vo0; asm volatile("" : "+v"(a0_)); \
    __builtin_amdgcn_global_load_lds((const unsigned*)(vb_ + a0_), (LAS unsigned*)(ld_), 16, 0, 0); __builtin_amdgcn_global_load_lds((const unsigned*)(vb_ + 8192 + a0_), (LAS unsigned*)(ld_ + 8192), 16, 0, 0); } while (0)
#define DMA_K(k0, b) do { const char* kb_ = (const char*)Kh + (size_t)(k0) * (DQK * 2); LAS char* ld_ = K_lds + (b) * SHM_K + wid * 1024; \
    unsigned a0_ = ko0, a1_ = ko1, a2_ = ko2; asm volatile("" : "+v"(a0_), "+v"(a1_), "+v"(a2_));     \
    __builtin_amdgcn_global_load_lds((const unsigned*)(kb_ + a0_), (LAS unsigned*)(ld_), 16, 0, 0); __builtin_amdgcn_global_load_lds((const unsigned*)(kb_ + a1_), (LAS unsigned*)(ld_ + 8192), 16, 0, 0); \
    __builtin_amdgcn_global_load_lds((const unsigned*)(kb_ + a2_), (LAS unsigned*)(ld_ + 16384), 16, 0, 0); \
    if (wid == 0) { unsigned a3_ = ko3; asm volatile("" : "+v"(a3_)); __builtin_amdgcn_global_load_lds((const unsigned*)(kb_ + a3_), (LAS unsigned*)(ld_ + 24576), 16, 0, 0); } } while (0)
#define KWAIT_BAR() do { asm volatile("s_waitcnt vmcnt(0)" ::: "memory"); __syncthreads(); } while (0)
#define SWAIT() asm volatile("s_waitcnt vmcnt(0)" ::: "memory")
#define RESC(a) do { if (__any((a) < 1.f)) { if (hi == 0) al_l[r32] = (a); asm volatile("s_waitcnt lgkmcnt(0)" ::: "memory"); \
    _Pragma("unroll") for (int d = 0; d < 4; ++d) _Pragma("unroll") for (int r = 0; r < 16; ++r) o[d][r] *= al_l[crow(r, hi)]; } } while (0)
    f32x16 pA0, pA1, pB0, pB1, negm; bf16x8 pa0, pa1, pa2, pa3; const int NT = seq / KVBLK;
    DMA_K(0, 0); DMA_K(KVBLK, 1); DMA_V(0, 0); KWAIT_BAR();
    qkt(pA0, pA1, Kl0, qr, Ql, f32x16{}); partialSM_first(pA0, pA1, negm);
    __syncthreads();
    for (int h = 1; h + 1 < NT; h += 2) {
        DMA_V(h * KVBLK, 1); DMA_K((h + 1) * KVBLK, 0);
        SBAR(); qkt(pB0, pB1, Kl0 + SHM_K, qr, Ql, negm);
        finishSM(pA0, pA1, l_reg, pa0, pa1, pa2, pa3); SBAR();
        pv_d0(o, vb0, pa0, pa1, pa2, pa3); partialSM(pB0, pB1, negm, l_reg, o, al_l, r32, hi);
        KWAIT_BAR();
        DMA_V((h + 1) * KVBLK, 0); DMA_K((h + 2) * KVBLK, 1);
        SBAR(); qkt(pA0, pA1, Kl0, qr, Ql, negm);
        finishSM(pB0, pB1, l_reg, pa0, pa1, pa2, pa3); SBAR();
        pv_d0(o, vb0 + SHM_V, pa0, pa1, pa2, pa3); partialSM(pA0, pA1, negm, l_reg, o, al_l, r32, hi);
        KWAIT_BAR();
    }
    DMA_V((NT - 1) * KVBLK, 1);
    SBAR(); qkt(pB0, pB1, Kl0 + SHM_K, qr, Ql, negm);
    finishSM(pA0, pA1, l_reg, pa0, pa1, pa2, pa3); SBAR();
    pv_d0(o, vb0, pa0, pa1, pa2, pa3); partialSM(pB0, pB1, negm, l_reg, o, al_l, r32, hi);
    KWAIT_BAR();
    finishSM(pB0, pB1, l_reg, pa0, pa1, pa2, pa3); SBAR();
    pv_d0(o, vb0 + SHM_V, pa0, pa1, pa2, pa3);
    if (hi == 0) li_l[r32] = l_reg; asm volatile("s_waitcnt lgkmcnt(0)" ::: "memory");
    float rli[16];
#pragma unroll
    for (int r = 0; r < 16; ++r) rli[r] = __builtin_amdgcn_rcpf(li_l[crow(r, hi)]);
    char* Ow = (char*)Ob + (size_t)(wid * QBLK) * DM * 2; const unsigned ooff = (unsigned)(4 * hi * DM + r32) * 2u;
#pragma unroll
    for (int r = 0; r < 16; ++r) {
#pragma unroll
        for (int d0 = 0; d0 < 4; ++d0) *(bf16*)(Ow + (((r & 3) + 8 * (r >> 2)) * DM + d0 * 32) * 2 + ooff) = (bf16)f2bf(o[d0][r] * rli[r]); }
    __syncthreads();
#undef DMA_K
#undef KWAIT_BAR
#undef DMA_V
#undef SWAIT
#undef RESC
}
}

#ifndef DUP_MASK
#define DUP_MASK 0
#endif
#define NREP(j) (1 + ((DUP_MASK >> (j)) & 1))
struct Ctx { LAS unsigned char* lds; int tid, lane, wave, bid, G; };
#define WSP(T, off) ((T*)(GAS T*)(wsb + (off)))
#define INP(i) ((const float*)(const GAS float*)a.in[i])
#define WSW(T, off, l) WSP(T, WS_WSET + (size_t)(l) * WSET_STRIDE + (off))
#define PHASE_BEGIN() Ctx c = c0; { int t_ = c0.tid; asm volatile("" : "+v"(t_)); c.tid = t_; c.lane = t_ & 63; c.wave = __builtin_amdgcn_readfirstlane(t_ >> 6); } \
    GAS unsigned char* wsb = (GAS unsigned char*)a.ws; asm volatile("" : "+s"(wsb));

__device__ __forceinline__ void convert_tile(const Args& a, GAS unsigned char* wsb, int l, int t, LAS float* scr, int lane);
__device__ __forceinline__ void convert_misc(const Args& a, GAS unsigned char* wsb, int l, int gt, int NGT);
__device__ __forceinline__ void mod_items(const Args& a, const Ctx& c0, int l) {
    PHASE_BEGIN();
    __syncthreads();
    LAS float* sc = (LAS float*)c.lds;
    LAS float* red = (LAS float*)(c.lds + 40960);
    for (int i = c.tid; i < 5 * DM; i += 512) { const int r = i >> 11, k = i & 2047; const float v = r < 4 ? INP(1)[r * DM + k] : INP(3)[k]; sc[i] = silu_(v); }
    __syncthreads();
    const int cl = c.tid & 15, kg = c.tid >> 4;
    float* modv = WSP(float, WS_MODV);
    for (int cb = c.bid; cb < 192; cb += c.G) {
        const float* w = INP(4) + (size_t)l * DM * NMODW + cb * 64 + cl * 4;
        f32x4 acc[5];
#pragma unroll
        for (int r = 0; r < 5; ++r) acc[r] = (f32x4){0.f, 0.f, 0.f, 0.f};
#pragma unroll 4
        for (int k = kg; k < DM; k += 32) { const f32x4 wv = *(const f32x4*)(w + (size_t)k * NMODW);
#pragma unroll
            for (int r = 0; r < 5; ++r) acc[r] += sc[r * DM + k] * wv; }
#pragma unroll
        for (int r = 0; r < 5; ++r) *(LAS f32x4*)(red + (kg * 5 + r) * 64 + cl * 4) = acc[r];
        __syncthreads();
        if (c.tid < 320) { const int r = c.tid >> 6, cc = c.tid & 63; float s = 0.f;
            for (int g = 0; g < 32; ++g) s += red[(g * 5 + r) * 64 + cc];
            modv[(size_t)(l * 5 + r) * NMODW + cb * 64 + cc] = s + INP(5)[(size_t)l * NMODW + cb * 64 + cc]; }
        __syncthreads();
    }
}
__device__ __forceinline__ void phase_mod(const Args& a, const Ctx& c0) {
    { PHASE_BEGIN();
      LAS float* scr = (LAS float*)(c.lds + c.wave * 16640); for (int t = c.bid * 8 + c.wave; t < T_SMALL; t += c.G * 8) convert_tile(a, wsb, 0, t, scr, c.lane);
      convert_misc(a, wsb, 0, c.bid * 512 + c.tid, c.G * 512); convert_misc(a, wsb, 1, c.bid * 512 + c.tid, c.G * 512); }
    mod_items(a, c0, 0);
}

__device__ __forceinline__ void tr_item(const float* W, int ldw, int k0, int n0, bf16* WT, int ldt, int drow0, LAS float* scr, int lane, const float* kscale = nullptr) {
    const float* src = W + (size_t)(k0 + (lane >> 4)) * ldw + n0 + (lane & 15) * 4;
    f32x4 v[16];
#pragma unroll
    for (int i = 0; i < 16; ++i) v[i] = __builtin_nontemporal_load((const f32x4*)(src + (size_t)(4 * i) * ldw));
    LAS float* wp = scr + (lane >> 4) * 65 + (lane & 15) * 4;
#pragma unroll
    for (int i = 0; i < 16; ++i) { LAS float* q = wp + (4 * i) * 65; const float ks = kscale ? kscale[k0 + 4 * i + (lane >> 4)] : 1.f; q[0] = v[i].x * ks; q[1] = v[i].y * ks; q[2] = v[i].z * ks; q[3] = v[i].w * ks; }
    asm volatile("s_waitcnt lgkmcnt(0)" ::: "memory");
    const int kc = lane & 7;
#pragma unroll
    for (int j = 0; j < 8; ++j) { const int n = (lane >> 3) + 8 * j; const LAS float* sp = scr + (8 * kc) * 65 + n;
        u32x4 o; o.x = pk2(sp[0 * 65], sp[1 * 65]); o.y = pk2(sp[2 * 65], sp[3 * 65]); o.z = pk2(sp[4 * 65], sp[5 * 65]); o.w = pk2(sp[6 * 65], sp[7 * 65]);
        __builtin_nontemporal_store(o, (u32x4*)(WT + (size_t)(drow0 + n) * ldt + k0 + 8 * kc)); }
    asm volatile("s_waitcnt lgkmcnt(0)" ::: "memory");
}
__device__ __forceinline__ void tr_item8(const float* W, int ldw, int k0, int n0, unsigned char* WT, int ldt, int drow0, LAS float* scr, int lane) {
    const float* src = W + (size_t)(k0 + (lane >> 4)) * ldw + n0 + (lane & 15) * 4;
    f32x4 v[16];
#pragma unroll
    for (int i = 0; i < 16; ++i) v[i] = __builtin_nontemporal_load((const f32x4*)(src + (size_t)(4 * i) * ldw));
    LAS float* wp = scr + (lane >> 4) * 65 + (lane & 15) * 4;
#pragma unroll
    for (int i = 0; i < 16; ++i) { LAS float* q = wp + (4 * i) * 65; q[0] = v[i].x * W8_SCALE; q[1] = v[i].y * W8_SCALE; q[2] = v[i].z * W8_SCALE; q[3] = v[i].w * W8_SCALE; }
    asm volatile("s_waitcnt lgkmcnt(0)" ::: "memory");
    const int kc = lane & 7;
#pragma unroll
    for (int j = 0; j < 8; ++j) { const int n = (lane >> 3) + 8 * j; const LAS float* sp = scr + (8 * kc) * 65 + n;
        u32x2 o; o.x = pk4_fp8(sp[0 * 65], sp[1 * 65], sp[2 * 65], sp[3 * 65]); o.y = pk4_fp8(sp[4 * 65], sp[5 * 65], sp[6 * 65], sp[7 * 65]);
        __builtin_nontemporal_store(o, (u32x2*)(WT + (size_t)(drow0 + n) * ldt + k0 + 8 * kc)); }
    asm volatile("s_waitcnt lgkmcnt(0)" ::: "memory");
}
__device__ __forceinline__ void norm_mod_row(const float* xrow, const float* g, const float* sh, const float* scl, bf16* orow, int lane) {
    f32x4 v[8], gs[8], sv[8]; float s = 0.f;
#pragma unroll
    for (int j = 0; j < 8; ++j) v[j] = ((const f32x4*)xrow)[lane + 64 * j];
#pragma unroll
    for (int j = 0; j < 8; ++j) { const int idx = (lane + 64 * j) * 4; gs[j] = *(const f32x4*)(g + idx) * (1.f + *(const f32x4*)(scl + idx)); sv[j] = *(const f32x4*)(sh + idx); }
#pragma unroll
    for (int j = 0; j < 8; ++j) s += dot4(v[j], v[j]);
    const float rstd = rsqrtf(wave_sum(s) * (1.f / DM) + EPS);
#pragma unroll
    for (int j = 0; j < 8; ++j) { const int idx = (lane + 64 * j) * 4; const f32x4 o = (v[j] * rstd) * gs[j] + sv[j];
        u32x2 w; w.x = pk2(o.x, o.y); w.y = pk2(o.z, o.w); *(u32x2*)(orow + idx) = w; }
}
__device__ __forceinline__ const float* xin_row(const Args& a, GAS unsigned char* wsb, int l, int row) {
    if (l == 0) return row < NL ? INP(0) + (size_t)row * DM : INP(2) + (size_t)(row - NL) * DM;
    return WSP(const float, WS_X1) + (size_t)row * DM;
}
__device__ __forceinline__ void convert_tile(const Args& a, GAS unsigned char* wsb, int l, int t, LAS float* scr, int lane) {
    constexpr int I_IN = 32 * 45, I_UQ = 8 * 24, I_UKV = 4 * 32, I_OUT = 32 * 32, I_EXP = 32 * 32;
    int r = t;
    if (r < I_IN) { const int kb = r / 45, nb = r - kb * 45; tr_item(INP(7) + (size_t)l * DM * INW, INW, kb * 64, nb * 64, WSW(bf16, W_IN, l), DM, nb * 64, scr, lane); return; }
    r -= I_IN;
    if (r < I_UQ) { const int kb = r / 24, nb = r - kb * 24; tr_item(INP(16) + (size_t)l * QRANK * 1536, 1536, kb * 64, nb * 64, WSW(bf16, W_UQ, l), QRANK, nb * 64, scr, lane, INP(15) + (size_t)l * QRANK); return; }
    r -= I_UQ;
    if (r < I_UKV) { const int kb = r / 32, nb = r - kb * 32; tr_item(INP(18) + (size_t)l * KVRANK * 2048, 2048, kb * 64, nb * 64, WSW(bf16, W_UKV, l), KVRANK, nb * 64, scr, lane, INP(17) + (size_t)l * KVRANK); return; }
    r -= I_UKV;
    if (r < I_OUT) { const int kb = r / 32, nb = r - kb * 32; tr_item(INP(21) + (size_t)l * DM * DM, DM, kb * 64, nb * 64, WSW(bf16, W_OUT, l), DM, nb * 64, scr, lane); return; }
    r -= I_OUT;
    const int which = r / (NE * I_EXP); r -= which * (NE * I_EXP);
    const int e = r / I_EXP; r -= e * I_EXP; const int kb = r / 32, nb = r - kb * 32, n0 = nb * 64;
    const float* W = INP(24 + which) + ((size_t)l * NE + e) * DM * DM;
    if (which == 0)      tr_item8(W, DM, kb * 64, n0, WSW(unsigned char, W_GU, l), DM, e * 4096 + (n0 >> 7) * 256 + (n0 & 127), scr, lane);
    else if (which == 1) tr_item8(W, DM, kb * 64, n0, WSW(unsigned char, W_GU, l), DM, e * 4096 + (n0 >> 7) * 256 + 128 + (n0 & 127), scr, lane);
    else                 tr_item8(W, DM, kb * 64, n0, WSW(unsigned char, W_DN, l), DM, e * 2048 + n0, scr, lane);
}
__device__ __forceinline__ void convert_misc(const Args& a, GAS unsigned char* wsb, int l, int gt, int NGT) {
    { u32x4* z = (u32x4*)(WSW(bf16, W_IN, l) + (size_t)INW * DM); for (int i = gt; i < (INWP - INW) * DM / 8; i += NGT) z[i] = (u32x4){0u, 0u, 0u, 0u}; }
    { bf16* wg = WSW(bf16, W_GT, l);
      for (int i = gt; i < 4096 * 128; i += NGT) { const int ng = i >> 7, kk = i & 127, pn = ng >> 8, n = ng & 255, dir = pn >> 3, gblk = pn & 7, j = n & 127;
          const float* src = (n < 128 ? INP(10) : INP(12)) + ((size_t)((l * 2 + dir) * 8 + gblk)) * 128 * 128;
          wg[i] = (bf16)f2bf(src[kk * 128 + j]); } }
    { float* lsl = WSP(float, WS_LSL) + (size_t)l * 2 * RW; const float* lm = INP(14) + (size_t)l * 2 * RW; for (int i = gt; i < 2 * RW; i += NGT) lsl[i] = -8.f * log1pf(expf(-lm[i])); }
}
__device__ __forceinline__ void bg_fill(const Args& a, const Ctx& c0, int site, int must) {
    PHASE_BEGIN();
    unsigned* ctl = WSP(unsigned, WS_CTL); unsigned* head = ctl + CW_QHEAD; unsigned* done = ctl + CW_QDONE + 64 * site;
    volatile LAS unsigned* bc = (volatile LAS unsigned*)(c.lds + LDS_MISC + 64);
    LAS float* scr = (LAS float*)(c.lds + c.wave * 16640);
    __syncthreads();
    if (c.tid == 0) (void)__hip_atomic_fetch_add(done, 1u, __ATOMIC_RELAXED, __HIP_MEMORY_SCOPE_AGENT);
    for (;;) {
        if (c.tid == 0) { unsigned s = 0xffffffffu;
            const unsigned h = __hip_atomic_load(head, __ATOMIC_RELAXED, __HIP_MEMORY_SCOPE_AGENT);
            bool go = h < (unsigned)must;
            if (!go && h < (unsigned)BG_STEPS) go = __hip_atomic_load(done, __ATOMIC_RELAXED, __HIP_MEMORY_SCOPE_AGENT) + 8u < (unsigned)c.G;
            if (go) { s = __hip_atomic_fetch_add(head, 1u, __ATOMIC_RELAXED, __HIP_MEMORY_SCOPE_AGENT); if (s >= (unsigned)BG_STEPS) s = 0xffffffffu; }
            bc[0] = s; }
        __syncthreads();
        const unsigned s = bc[0];
        if (s == 0xffffffffu) break;
        const int g = (int)s * 8 + c.wave;
        if (g < T_MOE) convert_tile(a, wsb, 0, T_SMALL + g, scr, c.lane); else convert_tile(a, wsb, 1, g - T_MOE, scr, c.lane);
        __syncthreads();
    }
}
__device__ __forceinline__ void bg_take(const Args& a, const Ctx& c0, int n) {
    PHASE_BEGIN();
    unsigned* head = WSP(unsigned, WS_CTL) + CW_QHEAD;
    volatile LAS unsigned* bc = (volatile LAS unsigned*)(c.lds + LDS_MISC + 64);
    LAS float* scr = (LAS float*)(c.lds + c.wave * 16640);
    __syncthreads();
    for (int i = 0; i < n; ++i) {
        if (c.tid == 0) { unsigned s = __hip_atomic_fetch_add(head, 1u, __ATOMIC_RELAXED, __HIP_MEMORY_SCOPE_AGENT); if (s >= (unsigned)BG_STEPS) s = 0xffffffffu; bc[0] = s; }
        __syncthreads();
        const unsigned s = bc[0];
        if (s == 0xffffffffu) break;
        const int g = (int)s * 8 + c.wave;
        if (g < T_MOE) convert_tile(a, wsb, 0, T_SMALL + g, scr, c.lane); else convert_tile(a, wsb, 1, g - T_MOE, scr, c.lane);
        __syncthreads();
    }
    __syncthreads();
}
__device__ __forceinline__ void phase_l0(const Args& a, const Ctx& c0, int l) {
    PHASE_BEGIN();
    const int gw = c.bid * 8 + c.wave, NGW = c.G * 8;
    const float* modv = WSP(const float, WS_MODV);
    for (int row = gw; row < NR; row += NGW) { const int mb = row < NL ? (row >> 12) : 4; const float* mv = modv + (size_t)mb * NMODW;
        norm_mod_row(xin_row(a, wsb, 0, row), INP(6), mv, mv + DM, WSP(bf16, WS_H) + (size_t)row * DM, c.lane); }
}

__device__ __forceinline__ void phase_conv(const Args& a, const Ctx& c0, int l) {
    PHASE_BEGIN();
    const bf16* XR = WSP(const bf16, WS_XR); bf16* U = WSP(bf16, WS_U);
    const float* cw = INP(8) + (size_t)l * 4 * RW; const float* cb = INP(9) + (size_t)l * RW;
    const int ch = (c.tid & 127) * 8, rg = c.tid >> 7;
    float w[4][8], bias[8];
#pragma unroll
    for (int k = 0; k < 4; ++k) { const f32x4 w0 = *(const f32x4*)(cw + k * RW + ch), w1 = *(const f32x4*)(cw + k * RW + ch + 4);
        w[k][0] = w0.x; w[k][1] = w0.y; w[k][2] = w0.z; w[k][3] = w0.w; w[k][4] = w1.x; w[k][5] = w1.y; w[k][6] = w1.z; w[k][7] = w1.w; }
    { const f32x4 b0 = *(const f32x4*)(cb + ch), b1 = *(const f32x4*)(cb + ch + 4); bias[0] = b0.x; bias[1] = b0.y; bias[2] = b0.z; bias[3] = b0.w; bias[4] = b1.x; bias[5] = b1.y; bias[6] = b1.z; bias[7] = b1.w; }
    for (int it = c.bid; it < NB * NCHUNK; it += c.G) {
        const int b = it / NCHUNK, cc = it - b * NCHUNK; const bool isc = cc < 4;
        const int seg0 = isc ? NL + b * CTXL : b * SEQ, T = isc ? CTXL : SEQ, t0 = (isc ? cc : cc - 4) * 64 + rg * 16;
        u32x4 x[19];
#pragma unroll
        for (int i = 0; i < 19; ++i) { const int t = t0 - 2 + i; x[i] = (t >= 0 && t < T) ? *(const u32x4*)(XR + (size_t)(seg0 + t) * RW + ch) : (u32x4){0u, 0u, 0u, 0u}; }
#pragma unroll
        for (int r = 0; r < 16; ++r) { float o[8];
#pragma unroll
            for (int e = 0; e < 8; ++e) o[e] = bias[e];
#pragma unroll
            for (int k = 0; k < 4; ++k) { const u32x4 xv = x[r + k];
                o[0] = fmaf(bflo(xv.x), w[k][0], o[0]); o[1] = fmaf(bfhi(xv.x), w[k][1], o[1]); o[2] = fmaf(bflo(xv.y), w[k][2], o[2]); o[3] = fmaf(bfhi(xv.y), w[k][3], o[3]);
                o[4] = fmaf(bflo(xv.z), w[k][4], o[4]); o[5] = fmaf(bfhi(xv.z), w[k][5], o[5]); o[6] = fmaf(bflo(xv.w), w[k][6], o[6]); o[7] = fmaf(bfhi(xv.w), w[k][7], o[7]); }
            u32x4 wv; wv.x = pk2(o[0], o[1]); wv.y = pk2(o[2], o[3]); wv.z = pk2(o[4], o[5]); wv.w = pk2(o[6], o[7]);
            *(u32x4*)(U + (size_t)(seg0 + t0 + r) * RW + ch) = wv; }
    }
}

__device__ __forceinline__ void phase_prep2(const Args& a, const Ctx& c0, int l, bool last) {
    PHASE_BEGIN();
    const int gw = c.bid * 8 + c.wave, NGW = c.G * 8, lane = c.lane, hh = lane >> 3, s = lane & 7;
    const float* KR = WSP(const float, WS_KR); const float* RSTDK = WSP(const float, WS_RSTDK);
    const float* kn = INP(20) + (size_t)l * DQK; bf16* Ko = WSP(bf16, WS_K);
    const float inv0 = exp2f(-(float)(2 * s) * (13.287712379549449f / 16.f)), inv1 = exp2f(-(float)(2 * s + 1) * (13.287712379549449f / 16.f));
    const f32x2 g1 = *(const f32x2*)(kn + 128 + 2 * s), g2 = *(const f32x2*)(kn + 144 + 2 * s), g3 = *(const f32x2*)(kn + 160 + 2 * s), g4 = *(const f32x2*)(kn + 176 + 2 * s);
    for (int row0 = gw * 2; row0 < NR; row0 += NGW * 2) {
        f32x2 r1[2], r2[2], c1[2], c2[2]; float rk[2];
#pragma unroll
        for (int q = 0; q < 2; ++q) { const float* kr = KR + (size_t)(row0 + q) * 64;
            r1[q] = *(const f32x2*)(kr + 2 * s); r2[q] = *(const f32x2*)(kr + 16 + 2 * s); c1[q] = *(const f32x2*)(kr + 32 + 2 * s); c2[q] = *(const f32x2*)(kr + 48 + 2 * s);
            rk[q] = RSTDK[(size_t)(row0 + q) * 8 + hh]; }
#pragma unroll
        for (int q = 0; q < 2; ++q) { const int row = row0 + q;
            const bool lat = row < NL; const int b = lat ? (row >> 12) : ((row - NL) >> 8); const int t = lat ? (row & (SEQ - 1)) : ((row - NL) & (CTXL - 1));
            const int pos = lat ? CTXL + t : t; const size_t hrow = (size_t)(b * NH + hh) * KVLEN + pos;
            float cr0 = 1.f, sr0 = 0.f, cr1 = 1.f, sr1 = 0.f, cc0 = 1.f, sc0 = 0.f, cc1 = 1.f, sc1 = 0.f;
            if (lat) { const float pr = (float)(t >> 6), pc = (float)(t & 63);
                __sincosf(pr * inv0, &sr0, &cr0); __sincosf(pr * inv1, &sr1, &cr1); __sincosf(pc * inv0, &sc0, &cc0); __sincosf(pc * inv1, &sc1, &cc1); }
            const f32x2 a1 = r1[q] * rk[q] * g1, a2 = r2[q] * rk[q] * g2, b1 = c1[q] * rk[q] * g3, b2 = c2[q] * rk[q] * g4;
            bf16* ko = Ko + hrow * DQK;
            *(unsigned*)(ko + 128 + 2 * s) = pk2(a1.x * cr0 - a2.x * sr0, a1.y * cr1 - a2.y * sr1);
            *(unsigned*)(ko + 144 + 2 * s) = pk2(a2.x * cr0 + a1.x * sr0, a2.y * cr1 + a1.y * sr1);
            *(unsigned*)(ko + 160 + 2 * s) = pk2(b1.x * cc0 - b2.x * sc0, b1.y * cc1 - b2.y * sc1);
            *(unsigned*)(ko + 176 + 2 * s) = pk2(b2.x * cc0 + b1.x * sc0, b2.y * cc1 + b1.y * sc1); }
    }
    const float* AGG = WSP(const float, WS_AGG); float* CAR = WSP(float, WS_CARRY);
    for (int rep = 0; rep < NREP(15); ++rep)
    for (int it = c.bid; it < 16; it += c.G) {
        const int b = it >> 2, dir = (it >> 1) & 1, ch = (it & 1) * 512 + c.tid;
        const float* P = AGG + ((size_t)(dir * 2 + 0) * NB * NCHUNK + b * NCHUNK) * RW + ch; const float* S = AGG + ((size_t)(dir * 2 + 1) * NB * NCHUNK + b * NCHUNK) * RW + ch;
        float* Co = CAR + ((size_t)dir * NB * NCHUNK + b * NCHUNK) * RW + ch;
        float run = 0.f;
        if (dir == 0) {
#pragma unroll 17
            for (int q = 0; q < NCHUNK; ++q) { Co[(size_t)q * RW] = run; run = fmaf(P[(size_t)q * RW], run, S[(size_t)q * RW]); }
        } else {
#pragma unroll
            for (int q = 3; q >= 0; --q) { Co[(size_t)q * RW] = run; run = fmaf(P[(size_t)q * RW], run, S[(size_t)q * RW]); }
#pragma unroll 16
            for (int q = NCHUNK - 1; q >= 4; --q) { Co[(size_t)q * RW] = run; run = fmaf(P[(size_t)q * RW], run, S[(size_t)q * RW]); }
        }
    }
}

__device__ __forceinline__ void phase_attn(const Args& a, const Ctx& c0, int l, bool last) {
    PHASE_BEGIN();
    const bf16* QRAW = WSP(const bf16, WS_QRAW); const float* SSQ = WSP(const float, WS_SSQ); const bf16* K = WSP(const bf16, WS_K); const bf16* V = WSP(const bf16, WS_V); bf16* Y = WSP(bf16, WS_Y);
    const float* qn = INP(19) + (size_t)l * DQK;
    const int nun = last ? 512 : 544;
    for (int rep = 0; rep < NREP(13); ++rep)
    for (int u = c.bid; u < nun; u += c.G) {
        const bool isl = u < 512; const int bh = isl ? (u >> 4) : (u - 512), qb = u & 15, b = bh >> 3, h = bh & 7;
        const int grow0 = isl ? b * SEQ + qb * 256 : NL + b * CTXL;
        int tu = c0.tid; asm volatile("" : "+v"(tu));
        att::attn_unit(QRAW + (size_t)grow0 * 1536 + h * DQK, SSQ + (size_t)grow0 * 16, qn, isl ? qb * 256 : -1, K + (size_t)bh * KVLEN * DQK, V + (size_t)bh * KVLEN * DVH,
                       Y + (size_t)grow0 * DM + RW + h * DVH, isl ? KVLEN : CTXL, (LAS char*)c.lds, tu);
    }
    const char* HP = (const char*)WSP(const char, WS_AB); const float* CAR = WSP(const float, WS_CARRY); const bf16* GR = WSP(const bf16, WS_GR);
    int tid2 = c0.tid; asm volatile("" : "+v"(tid2));
    const int g4 = (tid2 & 255) * 4, rh = tid2 >> 8;
    for (int rep = 0; rep < NREP(14); ++rep)
    for (int it = c.G - 1 - c.bid; it < NB * NCHUNK; it += c.G) {
        const int b = it / NCHUNK, cc = it - b * NCHUNK; if (last && cc < 4) continue;
        const int r0 = (cc < 4 ? NL + b * CTXL + cc * 64 : b * SEQ + (cc - 4) * 64) + rh * 32;
        const f32x4 cf = *(const f32x4*)(CAR + ((size_t)0 * NB * NCHUNK + it) * RW + g4), cb = *(const f32x4*)(CAR + ((size_t)1 * NB * NCHUNK + it) * RW + g4);
        const char* hf = HP + ((size_t)r0 * 1024 + g4) * 4; const char* hb = hf + (size_t)NR * 1024 * 4;
        const bf16* zg = GR + (size_t)r0 * RW + g4; bf16* yo = Y + (size_t)r0 * DM + g4;
#pragma unroll 8
        for (int r = 0; r < 32; ++r) {
            const u32x4 wf = *(const u32x4*)(hf + (size_t)r * 4096), wb = *(const u32x4*)(hb + (size_t)r * 4096); const u32x2 gw2 = *(const u32x2*)(zg + (size_t)r * RW); const f32x4 gr = {bflo(gw2.x), bfhi(gw2.x), bflo(gw2.y), bfhi(gw2.y)};
            const float h0 = fmaf(bflo(wf.z), cf.x, bflo(wf.x)) + fmaf(bflo(wb.z), cb.x, bflo(wb.x)), h1 = fmaf(bfhi(wf.z), cf.y, bfhi(wf.x)) + fmaf(bfhi(wb.z), cb.y, bfhi(wb.x));
            const float h2 = fmaf(bflo(wf.w), cf.z, bflo(wf.y)) + fmaf(bflo(wb.w), cb.z, bflo(wb.y)), h3 = fmaf(bfhi(wf.w), cf.w, bfhi(wf.y)) + fmaf(bfhi(wb.w), cb.w, bfhi(wb.y));
            u32x2 w; w.x = pk2(h0 * gelu_tanh_(gr.x), h1 * gelu_tanh_(gr.y)); w.y = pk2(h2 * gelu_tanh_(gr.z), h3 * gelu_tanh_(gr.w));
            *(u32x2*)(yo + (size_t)r * DM) = w; }
    }
}

__device__ __forceinline__ void phase_router(const Args& a, const Ctx& c0, int l, bool last, int skip) {
    PHASE_BEGIN();
    LAS float* rl = (LAS float*)c.lds;
    const float* rt = INP(23) + (size_t)l * DM * NE;
    for (int i = c.tid; i < DM * NE; i += 512) { const int k = i >> 4, e = i & 15; rl[e * DM + k] = rt[i]; }
    __syncthreads();
    const int gw = (c.bid - skip) * 8 + c.wave, NGW = (c.G - skip) * 8, lane = c.lane, nrows = last ? NL : NR;
    const float* modv = WSP(const float, WS_MODV) + (size_t)l * 5 * NMODW; const float* g = INP(22) + (size_t)l * DM;
    const bf16* XM = WSP(const bf16, WS_XM); float* AFF = WSP(float, WS_AFF);
    const int n1 = skip ? NL / 2 : nrows / 2; int j0 = gw - n1 % NGW; if (j0 < 0) j0 += NGW;
    for (int ph = 0; ph < (skip ? 2 : 1); ++ph) {
    if (ph == 1 && NL / 2 + j0 < NR / 2) {
        unsigned* flag = WSP(unsigned, WS_CTL) + CW_CTXMIX; unsigned sp = 0;
        while (__hip_atomic_load(flag, __ATOMIC_RELAXED, __HIP_MEMORY_SCOPE_AGENT) < (unsigned)skip) { __builtin_amdgcn_s_sleep(2); if (++sp > (1u << 22)) break; }
        __builtin_amdgcn_fence(__ATOMIC_ACQUIRE, "agent"); }
    const int pr0 = ph == 0 ? gw : NL / 2 + j0, prend = ph == 0 ? n1 : NR / 2;
    u32x2 wa[8], wb[8];
    if (pr0 < prend) {
#pragma unroll
        for (int j = 0; j < 8; ++j) { wa[j] = ((const u32x2*)(XM + (size_t)(pr0 * 2) * DM))[lane + 64 * j]; wb[j] = ((const u32x2*)(XM + (size_t)(pr0 * 2 + 1) * DM))[lane + 64 * j]; } }
    for (int pr = pr0; pr < prend; pr += NGW) {
        const int row = pr * 2; const int mb = row < NL ? (row >> 12) : 4; const float* sh = modv + (size_t)mb * NMODW + 3 * DM; const float* scl = sh + DM;
        f32x4 va[8], vb[8]; float sa = 0.f, sb = 0.f;
#pragma unroll
        for (int j = 0; j < 8; ++j) { va[j] = (f32x4){bflo(wa[j].x), bfhi(wa[j].x), bflo(wa[j].y), bfhi(wa[j].y)}; vb[j] = (f32x4){bflo(wb[j].x), bfhi(wb[j].x), bflo(wb[j].y), bfhi(wb[j].y)}; }
        if (pr + NGW < prend) { const int nrow = (pr + NGW) * 2;
#pragma unroll
            for (int j = 0; j < 8; ++j) { wa[j] = ((const u32x2*)(XM + (size_t)nrow * DM))[lane + 64 * j]; wb[j] = ((const u32x2*)(XM + (size_t)(nrow + 1) * DM))[lane + 64 * j]; } }
#pragma unroll
        for (int j = 0; j < 8; ++j) { sa += dot4(va[j], va[j]); sb += dot4(vb[j], vb[j]); }
        const float ra = rsqrtf(wave_sum(sa) * (1.f / DM) + EPS), rb = rsqrtf(wave_sum(sb) * (1.f / DM) + EPS);
        unsigned char* orow = WSP(unsigned char, WS_H) + (size_t)row * DM;
#pragma unroll
        for (int j = 0; j < 8; ++j) { const int idx = (lane + 64 * j) * 4;
            const f32x4 gsv = *(const f32x4*)(g + idx) * (1.f + *(const f32x4*)(scl + idx)), shv = *(const f32x4*)(sh + idx);
            va[j] = (va[j] * ra) * gsv + shv; vb[j] = (vb[j] * rb) * gsv + shv;
            *(unsigned*)(orow + idx) = pk4_fp8(va[j].x, va[j].y, va[j].z, va[j].w); *(unsigned*)(orow + DM + idx) = pk4_fp8(vb[j].x, vb[j].y, vb[j].z, vb[j].w); }
        __builtin_amdgcn_sched_barrier(0);
        float pa[16], pb[16];
        f32x2 ab[8][4];
#pragma unroll
        for (int j = 0; j < 8; ++j) { ab[j][0] = (f32x2){va[j].x, vb[j].x}; ab[j][1] = (f32x2){va[j].y, vb[j].y}; ab[j][2] = (f32x2){va[j].z, vb[j].z}; ab[j][3] = (f32x2){va[j].w, vb[j].w}; }
#pragma unroll
        for (int e = 0; e < 16; ++e) { f32x2 x2 = {0.f, 0.f};
#pragma unroll
            for (int j = 0; j < 8; ++j) { const f32x4 rv = *(const LAS f32x4*)(rl + e * DM + (lane + 64 * j) * 4);
                x2 = __builtin_elementwise_fma(ab[j][0], (f32x2){rv.x, rv.x}, x2); x2 = __builtin_elementwise_fma(ab[j][1], (f32x2){rv.y, rv.y}, x2);
                x2 = __builtin_elementwise_fma(ab[j][2], (f32x2){rv.z, rv.z}, x2); x2 = __builtin_elementwise_fma(ab[j][3], (f32x2){rv.w, rv.w}, x2); }
            pa[e] = x2.x; pb[e] = x2.y; if (e & 1) __builtin_amdgcn_sched_barrier(0); }
#define TR_STEP(N, BIT) _Pragma("unroll") for (int i = 0; i < N; ++i) { const bool up = (lane & BIT) != 0; \
            const float sA = up ? pa[i] : pa[i + N], kA = up ? pa[i + N] : pa[i], sB = up ? pb[i] : pb[i + N], kB = up ? pb[i + N] : pb[i]; \
            pa[i] = kA + __shfl_xor(sA, BIT); pb[i] = kB + __shfl_xor(sB, BIT); }
        TR_STEP(8, 32) TR_STEP(4, 16) TR_STEP(2, 8) TR_STEP(1, 4)
#undef TR_STEP
        float la = pa[0], lb = pb[0];
        la += __shfl_xor(la, 1); lb += __shfl_xor(lb, 1); la += __shfl_xor(la, 2); lb += __shfl_xor(lb, 2);
        float ma = la, mbx = lb;
#pragma unroll
        for (int o = 4; o < 64; o <<= 1) { ma = fmaxf(ma, __shfl_xor(ma, o)); mbx = fmaxf(mbx, __shfl_xor(mbx, o)); }
        const float ea = __expf(la - ma), eb = __expf(lb - mbx); float da = ea, db = eb;
#pragma unroll
        for (int o = 4; o < 64; o <<= 1) { da += __shfl_xor(da, o); db += __shfl_xor(db, o); }
        if ((lane & 3) == 0) { AFF[(size_t)row * NE + (lane >> 2)] = ea / da; AFF[(size_t)(row + 1) * NE + (lane >> 2)] = eb / db; }
    }
    }
}

__device__ __forceinline__ void phase_topk(const Args& a, const Ctx& c0, int l, bool last) {
    PHASE_BEGIN();
    LAS unsigned* hist = (LAS unsigned*)c.lds;
    LAS unsigned* misc = hist + 256;
    LAS unsigned* wtot = misc + 16;
    LAS int* selrow = (LAS int*)(wtot + 16);
    const float* AFF = WSP(const float, WS_AFF); int* SEL = WSP(int, WS_SEL); int* IDXR = WSP(int, WS_IDXR); float* GATEV = WSP(float, WS_GATEV);
    const unsigned char* H = WSP(const unsigned char, WS_H); unsigned char* XG = WSP(unsigned char, WS_XG);
    const int tid = c.tid, lane = c.lane, wave = c.wave;
    const int nit = last ? 256 : 320;
    for (int it = c.bid; it < nit; it += c.G) {
        const int seg = it >= 256 ? 1 : 0, bi = seg ? it - 256 : (it >> 2), qd = seg ? 0 : (it & 3), b = bi >> 4, e = bi & 15;
        const int T = seg ? CTXL : SEQ, cap = seg ? CAP_C : CAP_L, row0 = seg ? NL + b * CTXL : b * SEQ, slot0 = seg ? NB * CAP_L + b * CAP_C : b * CAP_L;
        const int capq = seg ? CAP_C : CAP_L / 4; const unsigned slo = (unsigned)(qd * capq), shi = slo + (unsigned)capq; const int tq = T / (seg ? 1 : 4);
        unsigned k[8];
#pragma unroll
        for (int j = 0; j < 8; ++j) { const int t = tid * 8 + j; k[j] = t < T ? __float_as_uint(AFF[(size_t)(row0 + t) * NE + e]) : 0u; }
        unsigned prefix = 0u, mask = 0u, want = (unsigned)cap;
        for (int pass = 0; pass < 4; ++pass) { const int shift = 24 - 8 * pass;
            if (tid < 256) hist[tid] = 0u;
            __syncthreads();
#pragma unroll
            for (int j = 0; j < 8; ++j) if ((k[j] & mask) == prefix) atomicAdd((unsigned*)&hist[(k[j] >> shift) & 255u], 1u);
            __syncthreads();
            if (tid == 0) { unsigned cum = 0u; int d = 255; for (; d > 0; --d) { const unsigned hh = hist[d]; if (cum + hh >= want) break; cum += hh; } misc[0] = (unsigned)d; misc[1] = want - cum; }
            __syncthreads();
            prefix |= misc[0] << shift; mask |= 255u << shift; want = misc[1];
            __syncthreads();
        }
        const unsigned thr = prefix;
        unsigned cnt = 0u;
#pragma unroll
        for (int j = 0; j < 8; ++j) cnt += (k[j] > thr ? 1u : 0u) + (k[j] == thr ? 0x10000u : 0u);
        unsigned inc = cnt;
#pragma unroll
        for (int o = 1; o < 64; o <<= 1) { const unsigned v = __shfl_up(inc, o); if (lane >= o) inc += v; }
        if (lane == 63) wtot[wave] = inc;
        __syncthreads();
        unsigned base = 0u;
        for (int w = 0; w < wave; ++w) base += wtot[w];
        unsigned run = base + inc - cnt;
        unsigned gt_run = run & 0xffffu, eq_run = run >> 16;
#pragma unroll
        for (int j = 0; j < 8; ++j) { const int t = tid * 8 + j;
            if (t < T) { const bool g = k[j] > thr, q = k[j] == thr; const bool sel = g || (q && eq_run < want);
                const unsigned slot = gt_run + (eq_run < want ? eq_run : want);
                if (sel && slot >= slo && slot < shi) { IDXR[e * EROWS + slot0 + slot] = row0 + t; GATEV[e * EROWS + slot0 + slot] = __uint_as_float(k[j]); selrow[slot - slo] = row0 + t;
                    SEL[(size_t)(row0 + t) * NE + e] = (int)(slot0 + slot); }
                if (!sel && t / tq == qd) SEL[(size_t)(row0 + t) * NE + e] = -1;
                gt_run += g ? 1u : 0u; eq_run += q ? 1u : 0u; } }
        __syncthreads();
        for (int s0 = wave * 8; s0 < capq; s0 += 64) {
            u32x4 t[8][2];
#pragma unroll
            for (int q = 0; q < 8; ++q) { const u32x4* src = (const u32x4*)(H + (size_t)selrow[s0 + q] * DM);
#pragma unroll
                for (int j = 0; j < 2; ++j) t[q][j] = src[lane + 64 * j]; }
#pragma unroll
            for (int q = 0; q < 8; ++q) { u32x4* dst = (u32x4*)(XG + ((size_t)e * EROWS + slot0 + slo + s0 + q) * DM);
#pragma unroll
                for (int j = 0; j < 2; ++j) dst[lane + 64 * j] = t[q][j]; } }
        if (seg == 1 && b == 0) {
            u32x4* dst = (u32x4*)(XG + ((size_t)e * EROWS + 2176) * DM);
            for (int i = tid; i < 128 * DM / 16; i += 512) dst[i] = (u32x4){0u, 0u, 0u, 0u};
            if (tid < 128) GATEV[e * EROWS + 2176 + tid] = 0.f; }
        __syncthreads();
    }
}

__device__ __forceinline__ void phase_combine(const Args& a, const Ctx& c0, int l, bool last_in) {
    PHASE_BEGIN();
    const bool last = last_in;
    const int gw = c.bid * 8 + c.wave, NGW = c.G * 8, lane = c.lane, nrows = last ? NL : NR;
    const bf16* XM = WSP(const bf16, WS_XM); const int* SEL = WSP(const int, WS_SEL); const bf16* YE = WSP(const bf16, WS_YE);
    const float* modv = WSP(const float, WS_MODV) + (size_t)l * 5 * NMODW;
    float* out = a.out; bf16* x1o = WSP(bf16, WS_X1);
    for (int row = gw; row < nrows; row += NGW) {
        const int mb = row < NL ? (row >> 12) : 4; const float* g2 = modv + (size_t)mb * NMODW + 5 * DM;
        const int myslot = lane < 16 ? SEL[(size_t)row * NE + lane] : -1;
        f32x4 xv[4][2], gv[4][2];
#pragma unroll
        for (int j = 0; j < 4; ++j) { const int idx = (lane + 64 * j) * 8; const u32x4 xw = *(const u32x4*)(XM + (size_t)row * DM + idx);
            xv[j][0] = (f32x4){bflo(xw.x), bfhi(xw.x), bflo(xw.y), bfhi(xw.y)}; xv[j][1] = (f32x4){bflo(xw.z), bfhi(xw.z), bflo(xw.w), bfhi(xw.w)};
#pragma unroll
            for (int hlf = 0; hlf < 2; ++hlf) gv[j][hlf] = *(const f32x4*)(g2 + idx + hlf * 4); }
        f32x4 acc[4][2];
#pragma unroll
        for (int j = 0; j < 4; ++j) { acc[j][0] = (f32x4){0.f, 0.f, 0.f, 0.f}; acc[j][1] = (f32x4){0.f, 0.f, 0.f, 0.f}; }
        unsigned long long m = __ballot(myslot >= 0);
        while (m) { const int e = __builtin_ctzll(m); m &= m - 1; const int sl = __shfl(myslot, e);
            const u32x4* y = (const u32x4*)(YE + ((size_t)e * EROWS + sl) * DM);
#pragma unroll
            for (int j = 0; j < 4; ++j) { const u32x4 w = y[lane + 64 * j];
                acc[j][0] += (f32x4){bflo(w.x), bfhi(w.x), bflo(w.y), bfhi(w.y)}; acc[j][1] += (f32x4){bflo(w.z), bfhi(w.z), bflo(w.w), bfhi(w.w)}; } }
        float ssn = 0.f;
#pragma unroll
        for (int j = 0; j < 4; ++j) { const int idx = (lane + 64 * j) * 8;
#pragma unroll
            for (int hlf = 0; hlf < 2; ++hlf) { xv[j][hlf] = xv[j][hlf] + gv[j][hlf] * acc[j][hlf]; ssn += dot4(xv[j][hlf], xv[j][hlf]); }
            if (last) { *(f32x4*)(out + (size_t)row * DM + idx) = xv[j][0]; *(f32x4*)(out + (size_t)row * DM + idx + 4) = xv[j][1]; }
            else { u32x4 w; w.x = pk2(xv[j][0].x, xv[j][0].y); w.y = pk2(xv[j][0].z, xv[j][0].w); w.z = pk2(xv[j][1].x, xv[j][1].y); w.w = pk2(xv[j][1].z, xv[j][1].w); *(u32x4*)(x1o + (size_t)row * DM + idx) = w; } }
        if (!last) {
            const float* mv1 = modv + (size_t)5 * NMODW + (size_t)mb * NMODW; const float* g1n = INP(6) + (size_t)(l + 1) * DM;
            const float rstd = rsqrtf(wave_sum(ssn) * (1.f / DM) + EPS); bf16* hrow = WSP(bf16, WS_H) + (size_t)row * DM;
#pragma unroll
            for (int j = 0; j < 4; ++j) { const int idx = (lane + 64 * j) * 8; u32x4 w;
#pragma unroll
                for (int hlf = 0; hlf < 2; ++hlf) { const int ix = idx + hlf * 4; const f32x4 gsv = *(const f32x4*)(g1n + ix) * (1.f + *(const f32x4*)(mv1 + DM + ix)), shv = *(const f32x4*)(mv1 + ix);
                    const f32x4 o = (xv[j][hlf] * rstd) * gsv + shv;
                    if (hlf == 0) { w.x = pk2(o.x, o.y); w.y = pk2(o.z, o.w); } else { w.z = pk2(o.x, o.y); w.w = pk2(o.z, o.w); } }
                *(u32x4*)(hrow + idx) = w; } }
    }
}

constexpr int PH_PER_LAYER = 12, NPH = 1 + 2 * PH_PER_LAYER;
__global__ void __launch_bounds__(512, 2) mk_fwd(Args a) {
    extern __shared__ __attribute__((aligned(16))) unsigned char lds_raw[];
    Ctx c; c.lds = (LAS unsigned char*)lds_raw; c.tid = threadIdx.x; c.lane = c.tid & 63; c.wave = __builtin_amdgcn_readfirstlane(c.tid >> 6); c.bid = blockIdx.x; c.G = gridDim.x;
    volatile LAS unsigned* MISC = (volatile LAS unsigned*)(c.lds + LDS_MISC);
    if (c.tid < 32) MISC[c.tid] = 0u;
    __syncthreads();
    XcdBarrier bar; bar.bar = (unsigned*)(a.ws + WS_CTL) + 4096; bar.x = 0; bar.st = nullptr;
    const int lo = a.ph_lo, hi = a.ph_hi;
    if (hi - lo > 1) bar = xcd_barrier_post((unsigned*)(a.ws + WS_CTL) + 4096, MISC + 8);
#ifndef PH_MASK
#define PH_MASK 0x1fff
#endif
#define EN(j) ((PH_MASK >> (j)) & 1)

#define IN(k) (lo <= (k) && (k) < hi)
#define SEAM(k) do { if (IN(k) && IN((k) + 1)) { XcdBarrier b_ = bar; { GAS unsigned* t_ = (GAS unsigned*)b_.bar; asm volatile("" : "+s"(t_)); b_.bar = (unsigned*)t_; } xcd_barrier(b_); } } while (0)

    if (EN(12) && IN(0)) for (int rep = 0; rep < NREP(12); ++rep) { phase_mod(a, c); }
    SEAM(0);
    if (hi - lo > 1) {
        if (c.tid == 0) { unsigned* bw = (unsigned*)(a.ws + WS_CTL) + 4096; bool even = (c.G % 8) == 0;
            for (unsigned j = 0; j < 8; ++j) even = even && (xb_ld(&bw[XB_XCNT(j)]) == (unsigned)(c.G / 8));
            MISC[12] = even ? (MISC[10] * 8u + bar.x) : (unsigned)c.bid; }
        __syncthreads();
        c.bid = (int)MISC[12];
    }
    for (int l = 0; l < 2; ++l) {
        const int pb = 1 + l * PH_PER_LAYER; const bool last = (l == 1);
        if (l == 0) {
            if (EN(0) && IN(pb + 0)) for (int rep = 0; rep < NREP(0); ++rep) { phase_l0(a, c, l); }
            SEAM(pb + 0);
        }
        if (EN(1) && IN(pb + 1)) for (int rep = 0; rep < NREP(1); ++rep) {
            GAS unsigned char* wsb = (GAS unsigned char*)a.ws; asm volatile("" : "+s"(wsb));
            ProbIn p; p.K = DM; p.lda = DM; p.ldb = DM; p.ord.init(NR / 256, INWP / 256, c.G, c.bid); p.A = (const char*)WSP(bf16, WS_H); p.Bt = (const char*)WSW(bf16, W_IN, l);
            p.XR = WSP(bf16, WS_XR); p.GR = WSP(bf16, WS_GR); p.CQ = WSP(bf16, WS_CQ); p.CKV = WSP(bf16, WS_CKV); p.KR = WSP(float, WS_KR); p.SSQ = WSP(float, WS_SSQ);
            pg8::gemm_phase(c.lds, p); }
#if BG_FILL_GEMM_TAILS
        if (IN(pb + 1)) bg_fill(a, c, l * 8 + 1, 0);
#endif
        SEAM(pb + 1);
        if (EN(2) && IN(pb + 2)) for (int rep = 0; rep < NREP(2); ++rep) { phase_conv(a, c, l); }
        SEAM(pb + 2);
        if (EN(3) && IN(pb + 3)) for (int rep = 0; rep < NREP(3); ++rep) {
            GAS unsigned char* wsb = (GAS unsigned char*)a.ws; asm volatile("" : "+s"(wsb));
#ifndef NO_QKV
            { ProbQ p; p.K = QRANK; p.lda = QRANK; p.ldb = QRANK; p.ord.init((last ? NL : NR) / 256, 1536 / 256, c.G, c.bid); p.A = (const char*)WSP(bf16, WS_CQ); p.Bt = (const char*)WSW(bf16, W_UQ, l); p.O = WSP(bf16, WS_QRAW);
              pg8::gemm_phase(c.lds, p); }
            { ProbKV p; p.K = KVRANK; p.lda = KVRANK; p.ldb = KVRANK; p.ord.init(NR / 256, NH, c.G, (c.bid + c.G - 216) % c.G); p.A = (const char*)WSP(bf16, WS_CKV);   p.Bt = (const char*)WSW(bf16, W_UKV, l); p.Ko = WSP(bf16, WS_K); p.Vo = WSP(bf16, WS_V);
              p.SSQ = WSP(const float, WS_SSQ); p.RSTDK = WSP(float, WS_RSTDK); p.kn = INP(20) + (size_t)l * DQK; p.part = (LAS float*)(c.lds + 131072);
              pg8::gemm_phase(c.lds, p); }
#endif
#ifndef NO_GATES
            { ProbGates p; p.K = 128; p.lda = RW; p.ldb = 128; p.ord.init(NR / 256, 16, c.G, (c.bid + c.G - 152) % c.G); p.U = (const char*)WSP(bf16, WS_U);   p.Bt = (const char*)WSW(bf16, W_GT, l); p.HP = (char*)WSP(char, WS_AB); p.AGG = WSP(float, WS_AGG);
              p.ba = INP(11) + (size_t)l * 2 * RW; p.bx = INP(13) + (size_t)l * 2 * RW; p.lam = WSP(const float, WS_LSL) + (size_t)l * 2 * RW;
              pg8::gemm_phase(c.lds, p); }
#endif
        }
#if BG_FILL_GEMM_TAILS
        if (IN(pb + 3)) bg_fill(a, c, l * 8 + 2, 0);
#endif
        SEAM(pb + 3);
        if (EN(4) && IN(pb + 4)) for (int rep = 0; rep < NREP(4); ++rep) { phase_prep2(a, c, l, last); }
        SEAM(pb + 4);
        if (IN(pb + 5) && (c.bid & 1) == 0) { if (l == 0) mod_items(a, c, 1); bg_take(a, c, l == 0 ? (c.bid < 32 ? 22 : 27) : (c.bid >= 240 ? 21 : 24)); }
        if (EN(5) && IN(pb + 5)) for (int rep = 0; rep < NREP(5); ++rep) { phase_attn(a, c, l, last); }
        if (IN(pb + 5) && (c.bid & 1) == 1) { bg_take(a, c, l == 0 ? (c.bid < 32 ? 22 : 27) : (c.bid >= 240 ? 21 : 24)); if (l == 0) mod_items(a, c, 1); }
#if BG_FILL_GEMM_TAILS
        if (IN(pb + 5) && l == 0) bg_fill(a, c, 3, 0);
#endif
        SEAM(pb + 5);
        if (EN(6) && IN(pb + 6)) for (int rep = 0; rep < NREP(6); ++rep) {
            GAS unsigned char* wsb = (GAS unsigned char*)a.ws; asm volatile("" : "+s"(wsb));
            const bool split = !last && c.G >= 64;
            ProbMixer p; p.K = DM; p.lda = DM; p.ldb = DM; p.ord.init((last || split ? NL : NR) / 256, DM / 256, c.G, c.bid); p.pm0 = 0; p.A = (const char*)WSP(bf16, WS_Y); p.Bt = (const char*)WSW(bf16, W_OUT, l);
            p.xl = l == 0 ? INP(0) : nullptr; p.xc = l == 0 ? INP(2) : nullptr; p.x1 = WSP(const bf16, WS_X1); p.XM = WSP(bf16, WS_XM); p.modv = WSP(const float, WS_MODV) + (size_t)l * 5 * NMODW;
            pg8::gemm_phase(c.lds, p); }
#if BG_FILL_GEMM_TAILS
        if (IN(pb + 6) && l == 0) bg_fill(a, c, 4, 0);
#endif
        SEAM(pb + 6);
        if (EN(7) && IN(pb + 7)) for (int rep = 0; rep < NREP(7); ++rep) {
            const bool split = !last && c.G >= 64;
            if (split && c.bid < 32) {
                GAS unsigned char* wsb = (GAS unsigned char*)a.ws; asm volatile("" : "+s"(wsb));
                ProbMixer p; p.K = DM; p.lda = DM; p.ldb = DM; p.ord.init(NC / 256, DM / 256, 32, c.bid); p.pm0 = NL / 256; p.A = (const char*)WSP(bf16, WS_Y); p.Bt = (const char*)WSW(bf16, W_OUT, l);
                p.xl = l == 0 ? INP(0) : nullptr; p.xc = l == 0 ? INP(2) : nullptr; p.x1 = WSP(const bf16, WS_X1); p.XM = WSP(bf16, WS_XM); p.modv = WSP(const float, WS_MODV) + (size_t)l * 5 * NMODW;
                pg8::gemm_phase(c.lds, p);
                asm volatile("s_waitcnt vmcnt(0)" ::: "memory"); __syncthreads();
                if (threadIdx.x == 0) { __builtin_amdgcn_fence(__ATOMIC_RELEASE, "agent"); __hip_atomic_fetch_add(WSP(unsigned, WS_CTL) + CW_CTXMIX, 1u, __ATOMIC_RELAXED, __HIP_MEMORY_SCOPE_AGENT); }
            } else phase_router(a, c, l, last, split ? 32 : 0); }
        SEAM(pb + 7);
        if (EN(8) && IN(pb + 8)) for (int rep = 0; rep < NREP(8); ++rep) { phase_topk(a, c, l, last); }
        if (IN(pb + 8)) bg_fill(a, c, l * 8 + 5, l == 0 ? BG_E0 : BG_E1);
        SEAM(pb + 8);
        if (EN(9) && IN(pb + 9)) for (int rep = 0; rep < NREP(9); ++rep) {
            GAS unsigned char* wsb = (GAS unsigned char*)a.ws; asm volatile("" : "+s"(wsb));
            ProbGateUp p; p.K = DM; p.lda = DM; p.ldb = DM; p.tpe = last ? 8 : 9; p.ord.init(NE * p.tpe, 16, c.G, c.bid, p.tpe); p.XG = (const char*)WSP(unsigned char, WS_XG); p.Bt = (const char*)WSW(unsigned char, W_GU, l); p.ACT = WSP(unsigned char, WS_ACT);
            pg8::gemm_phase(c.lds, p); }
        SEAM(pb + 9);
        if (EN(10) && IN(pb + 10)) for (int rep = 0; rep < NREP(10); ++rep) {
            GAS unsigned char* wsb = (GAS unsigned char*)a.ws; asm volatile("" : "+s"(wsb));
            ProbDown p; p.K = DM; p.lda = DM; p.ldb = DM; p.tpe = last ? 8 : 9; p.ord.init(NE * p.tpe, 8, c.G, c.bid, p.tpe); p.ACT = (const char*)WSP(unsigned char, WS_ACT); p.Bt = (const char*)WSW(unsigned char, W_DN, l); p.YE = WSP(bf16, WS_YE); p.gatev = WSP(const float, WS_GATEV);
            pg8::gemm_phase(c.lds, p); }
#if BG_FILL_GEMM_TAILS
        if (IN(pb + 10) && l == 0) bg_fill(a, c, 6, 0);
#endif
        SEAM(pb + 10);
        if (EN(11) && IN(pb + 11)) for (int rep = 0; rep < NREP(11); ++rep) { phase_combine(a, c, l, last); }
        if (IN(pb + 11) && l == 0) bg_fill(a, c, 8, BG_E1S);
        SEAM(pb + 11);
    }
#undef IN
#undef SEAM
}

extern "C" void kernel_launch(void* const* d_in, const int* in_sizes, int n_in, void* d_out, int out_size, void* d_ws, size_t ws_size, hipStream_t stream) {
    static int grid = 0;
    if (grid == 0) {
        if (n_in != 27 || out_size != NL * DM || ws_size < WS_END) { fprintf(stderr, "kernel_launch: unexpected shapes (n_in %d out %d ws %zu)\n", n_in, out_size, ws_size); grid = -1; return; }
        int dev = 0, cus = 0, per_cu = 0;
        if (hipGetDevice(&dev) != hipSuccess || hipDeviceGetAttribute(&cus, hipDeviceAttributeMultiprocessorCount, dev) != hipSuccess) { grid = -1; return; }
        if (hipFuncSetAttribute((const void*)mk_fwd, hipFuncAttributeMaxDynamicSharedMemorySize, LDS_BYTES) != hipSuccess) { fprintf(stderr, "kernel_launch: hipFuncSetAttribute failed\n"); grid = -1; return; }
        if (hipOccupancyMaxActiveBlocksPerMultiprocessor(&per_cu, (const void*)mk_fwd, 512, LDS_BYTES) != hipSuccess || per_cu < 1) { fprintf(stderr, "kernel_launch: occupancy query says %d\n", per_cu); }
        (void)hipGetLastError();
        grid = cus;
    }
    if (grid < 0) return;
    (void)hipMemsetAsync((char*)d_ws + WS_CTL, 0, CTL_BYTES, stream);
    Args a{};
    for (int i = 0; i < 27; ++i) a.in[i] = (const float*)d_in[i];
    a.out = (float*)d_out; a.ws = (unsigned char*)d_ws;
#if MK_ONE_LAUNCH
    a.ph_lo = 0; a.ph_hi = NPH;
    hipLaunchKernelGGL(mk_fwd, dim3(grid), dim3(512), LDS_BYTES, stream, a);
#else
    for (int k = 0; k < NPH; ++k) { a.ph_lo = k; a.ph_hi = k + 1; hipLaunchKernelGGL(mk_fwd, dim3(grid), dim3(512), LDS_BYTES, stream, a); }
#endif
    const hipError_t le = hipPeekAtLastError();
    if (le != hipSuccess) fprintf(stderr, "kernel_launch: launch failed: %s\n", hipGetErrorName(le));
}
```
